# Optimizing an MI355X kernel written in HIP

```python
import jax, jax.numpy as jnp
from jax import lax
import numpy as np

D_MODEL = 1024
BATCH = 8
SEQ = 2048
DEPTH = 4

A_HEADS = 4
A_HEAD_DIM = 64
A_WIDTH = A_HEADS * A_HEAD_DIM
A_DECAY_LORA = 64
A_ICL_LORA = 64
A_GATE_LORA = 128
A_LN_EPS = 64e-5
B_HEADS = 4
B_HEAD_DIM = 64
B_WIDTH = B_HEADS * B_HEAD_DIM
B_CONV = 4
B_CHUNK = 128
C_Q_HEADS = 8
C_KV_HEADS = 2
C_HEAD_DIM = 64
C_WIDTH = C_Q_HEADS * C_HEAD_DIM
C_KV_WIDTH = C_KV_HEADS * C_HEAD_DIM
WINDOW = 128
C_BLOCK = 128
N_BRANCH = 3
N_GROUPS = 4
EXPERTS_PER_GROUP = 8
N_EXPERTS = N_GROUPS * EXPERTS_PER_GROUP
TOP_K = 2
D_EXPERT = 512
MOE_BLOCK = 128
EPS = 1e-6
ADA_GATE_INIT = 0.5

A_SIZES = (A_WIDTH, A_WIDTH, A_WIDTH, A_DECAY_LORA, A_ICL_LORA, A_GATE_LORA)
A_SHIFT_WIDTH = sum(A_SIZES)
REST_SIZES = (B_WIDTH, B_WIDTH, B_WIDTH, B_WIDTH, B_HEADS, B_HEADS,
              C_WIDTH, C_KV_WIDTH, C_KV_WIDTH, N_BRANCH * D_MODEL)
N_IN = A_SHIFT_WIDTH + sum(REST_SIZES)

kernel_name = 'hybrid_rwkv7_mlstm_swa_hmoe_block'


def _split(z, sizes):
    return jnp.split(z, np.cumsum(sizes)[:-1].tolist(), axis=-1)


def rms_norm(x, g):
    xf = x.astype(jnp.float32)
    y = xf * lax.rsqrt(jnp.mean(xf * xf, axis=-1, keepdims=True) + EPS)
    return (y * g).astype(x.dtype)


def token_shift(z):
    return jnp.pad(z, ((0, 0), (1, 0), (0, 0)))[:, :-1]


def causal_conv(x, w, b):
    K, C = w.shape
    y = lax.conv_general_dilated(x, w[:, None, :], window_strides=(1,), padding=((K - 1, 0),),
                                 dimension_numbers=('NWC', 'WIO', 'NWC'), feature_group_count=C)
    return y + b


def alibi_slopes(n):
    return jnp.exp2(-8.0 * jnp.arange(1, n + 1, dtype=jnp.float32) / n)


def rwkv7_time_mix(r, k, v, w_lo, a_lo, g_lo, w0, w2, a0, a2, g2, k_k, k_a, r_k, lnx_g, lnx_b):
    dt = r.dtype
    f32 = jnp.float32
    Bsz, T, _ = r.shape
    H, N = A_HEADS, A_HEAD_DIM
    r, k, v, w_lo, a_lo, g_lo = (z.astype(f32) for z in (r, k, v, w_lo, a_lo, g_lo))
    w_log = -jax.nn.softplus(-(w0 + jnp.tanh(w_lo) @ w2)) - 0.5
    decay = jnp.exp(-jnp.exp(w_log))
    a = jax.nn.sigmoid(a0 + a_lo @ a2)
    g = jax.nn.sigmoid(g_lo) @ g2
    heads = lambda z: z.reshape(Bsz, T, H, N)
    kk = heads(k * k_k)
    kk = kk / jnp.maximum(jnp.sqrt(jnp.sum(kk * kk, axis=-1, keepdims=True)), 1e-12)
    k = k * (1 + (a - 1) * k_a)
    rh, kh, vh, ah, wh = heads(r), heads(k), heads(v), heads(a), heads(decay)
    a_vec = -kk
    b_vec = kk * ah

    def step(S, inp):
        r_t, w_t, k_t, v_t, av_t, bv_t = inp
        sa = jnp.einsum('bhij,bhj->bhi', S, av_t)
        S = S * w_t[:, :, None, :] + sa[..., None] * bv_t[:, :, None, :] + v_t[..., None] * k_t[:, :, None, :]
        return S, jnp.einsum('bhij,bhj->bhi', S, r_t)

    S0 = jnp.zeros((Bsz, H, N, N), f32)
    _, y = lax.scan(step, S0, tuple(jnp.moveaxis(z, 1, 0) for z in (rh, wh, kh, vh, a_vec, b_vec)))
    y = jnp.moveaxis(y, 0, 1)
    mu = jnp.mean(y, axis=-1, keepdims=True)
    var = jnp.mean(jnp.square(y - mu), axis=-1, keepdims=True)
    y = ((y - mu) * lax.rsqrt(var + A_LN_EPS)).reshape(Bsz, T, A_WIDTH) * lnx_g + lnx_b
    bonus = jnp.sum(rh * kh * r_k, axis=-1, keepdims=True) * vh
    y = (y + bonus.reshape(Bsz, T, A_WIDTH)) * g
    return y.astype(dt)


def mlstm_chunkwise(q, k, v, o, i_pre, f_pre, conv_w, conv_b, b_i, b_f, hn_g):
    dt = q.dtype
    f32 = jnp.float32
    Bsz, T, _ = q.shape
    H, d, L = B_HEADS, B_HEAD_DIM, B_CHUNK
    NC = T // L
    qk = jax.nn.silu(causal_conv(jnp.concatenate([q, k], axis=-1), conv_w, conv_b))
    q, k = jnp.split(qk, 2, axis=-1)
    chunks = lambda z: z.reshape(Bsz, NC, L, H, d).transpose(0, 3, 1, 2, 4).astype(f32)
    qc, kc, vc = chunks(q), chunks(k) * d ** -0.5, chunks(v)
    gate_chunks = lambda z: z.astype(f32).reshape(Bsz, NC, L, H).transpose(0, 3, 1, 2)
    ig = gate_chunks(i_pre + b_i)
    logf = jax.nn.log_sigmoid(gate_chunks(f_pre + b_f))
    F = jnp.cumsum(logf, axis=-1)
    F_last = F[..., -1]
    g_end = F_last[..., None] - F + ig

    def chunk_step(carry, inp):
        C, n, m = carry
        k_c, v_c, g_c, fl_c = inp
        m_new = jnp.maximum(fl_c + m, jnp.max(g_c, axis=-1))
        carry_decay = jnp.exp(fl_c + m - m_new)
        w = jnp.exp(g_c - m_new[..., None])
        C_new = carry_decay[..., None, None] * C + jnp.einsum('bhs,bhsd,bhse->bhde', w, v_c, k_c)
        n_new = carry_decay[..., None] * n + jnp.einsum('bhs,bhse->bhe', w, k_c)
        return (C_new, n_new, m_new), (C, n, m)

    init = (jnp.zeros((Bsz, H, d, d), f32), jnp.zeros((Bsz, H, d), f32), jnp.zeros((Bsz, H), f32))
    cm = lambda z: jnp.moveaxis(z, 2, 0)
    _, (C0, n0, m0) = lax.scan(chunk_step, init, (cm(kc), cm(vc), cm(g_end), cm(F_last)))
    C0 = jnp.moveaxis(C0, 0, 2)
    n0 = jnp.moveaxis(n0, 0, 2)
    m0 = jnp.moveaxis(m0, 0, 2)
    D = F[..., :, None] - F[..., None, :] + ig[..., None, :]
    D = jnp.where(jnp.tril(jnp.ones((L, L), bool)), D, -jnp.inf)
    g_inter = F + m0[..., None]
    m_t = jnp.maximum(g_inter, jnp.max(D, axis=-1))
    Sw = jnp.einsum('bhctd,bhcsd->bhcts', qc, kc) * jnp.exp(D - m_t[..., None])
    inter = jnp.exp(g_inter - m_t)
    num = jnp.einsum('bhcts,bhcsd->bhctd', Sw, vc) + inter[..., None] * jnp.einsum('bhcde,bhcte->bhctd', C0, qc)
    den = jnp.sum(Sw, axis=-1) + inter * jnp.einsum('bhcd,bhctd->bhct', n0, qc)
    h = num / jnp.maximum(jnp.abs(den), jnp.exp(-m_t))[..., None]
    h = h.transpose(0, 2, 3, 1, 4).reshape(Bsz, T, H, d)
    h = h * lax.rsqrt(jnp.mean(h * h, axis=-1, keepdims=True) + EPS) * hn_g
    h = h.reshape(Bsz, T, B_WIDTH) * jax.nn.sigmoid(o.astype(f32))
    return h.astype(dt)


def sliding_window_sink_attention(q, k, v, qn_g, kn_g, sinks):
    dt = q.dtype
    f32 = jnp.float32
    Bsz, T, _ = q.shape
    Hkv, d, Bk = C_KV_HEADS, C_HEAD_DIM, C_BLOCK
    G = C_Q_HEADS // Hkv
    NB = T // Bk

    def hnorm(z, g):
        z = z.astype(f32)
        return z * lax.rsqrt(jnp.mean(z * z, axis=-1, keepdims=True) + EPS) * g

    qh = hnorm(q.reshape(Bsz, NB, Bk, Hkv, G, d), qn_g) * d ** -0.5
    kh = hnorm(k.reshape(Bsz, NB, Bk, Hkv, d), kn_g)
    vh = v.reshape(Bsz, NB, Bk, Hkv, d).astype(f32)

    def band(z):
        prev = jnp.pad(z, ((0, 0), (1, 0), (0, 0), (0, 0), (0, 0)))[:, :-1]
        return jnp.concatenate([prev, z], axis=2)

    kb, vb = band(kh), band(vh)
    s = jnp.einsum('bnqkgd,bnskd->bkgnqs', qh, kb)
    blk = jnp.arange(NB)[:, None, None]
    q_pos = blk * Bk + jnp.arange(Bk)[None, :, None]
    k_pos = (blk - 1) * Bk + jnp.arange(2 * Bk)[None, None, :]
    dist = q_pos - k_pos
    valid = (dist >= 0) & (dist < WINDOW) & (k_pos >= 0)
    slopes = alibi_slopes(C_Q_HEADS).reshape(Hkv, G)[None, :, :, None, None, None]
    s = jnp.where(valid, s - slopes * dist.astype(f32), -jnp.inf)
    sink = sinks.astype(f32).reshape(Hkv, G)[None, :, :, None, None, None]
    m = jnp.maximum(jnp.max(s, axis=-1, keepdims=True), sink)
    p = jnp.exp(s - m)
    den = jnp.sum(p, axis=-1, keepdims=True) + jnp.exp(sink - m)
    out = jnp.einsum('bkgnqs,bnskd->bnqkgd', p / den, vb)
    return out.reshape(Bsz, T, C_WIDTH).astype(dt)


def hybrid_mixer(h, w_in, mu_a, w0_a, w2_a, a0_a, a2_a, g2_a, kk_a, ka_a, rk_a, lnx_g_a, lnx_b_a,
                 conv_w_b, conv_b_b, bi_b, bf_b, hn_g_b, qn_g_c, kn_g_c, sink_c,
                 w_br_a, w_br_b, w_br_c, w_out):
    p = h @ w_in
    p_a, p_rest = p[..., :A_SHIFT_WIDTH], p[..., A_SHIFT_WIDTH:]
    p_a = p_a + mu_a * (token_shift(p_a) - p_a)
    rA, kA, vA, wloA, aloA, gloA = _split(p_a, A_SIZES)
    qB, kB, vB, oB, iB, fB, qC, kC, vC, gate_logits = _split(p_rest, REST_SIZES)
    y_a = rwkv7_time_mix(rA, kA, vA, wloA, aloA, gloA, w0_a, w2_a, a0_a, a2_a, g2_a,
                         kk_a, ka_a, rk_a, lnx_g_a, lnx_b_a)
    y_b = mlstm_chunkwise(qB, kB, vB, oB, iB, fB, conv_w_b, conv_b_b, bi_b, bf_b, hn_g_b)
    y_c = sliding_window_sink_attention(qC, kC, vC, qn_g_c, kn_g_c, sink_c)
    g_a, g_b, g_c = jnp.split(jax.nn.sigmoid(gate_logits), N_BRANCH, axis=-1)
    merged = g_a * (y_a @ w_br_a) + g_b * (y_b @ w_br_b) + g_c * (y_c @ w_br_c)
    return merged @ w_out


def hier_moe(h, w_rg, b_rg, w_re, b_re, w_e_in, w_e_out):
    f32 = jnp.float32
    Bsz, T, D = h.shape
    x = h.reshape(-1, D)
    NT = x.shape[0]
    g_prob = jax.nn.softmax((x @ w_rg).astype(f32) + b_rg.astype(f32), axis=-1)
    g_top, g_idx = lax.top_k(g_prob, 1)
    e_logits = ((x @ w_re).astype(f32) + b_re.astype(f32)).reshape(NT, N_GROUPS, EXPERTS_PER_GROUP)
    e_in_group = jnp.take_along_axis(e_logits, g_idx[:, :, None], axis=1)[:, 0]
    e_top, e_idx = lax.top_k(jax.nn.softmax(e_in_group, axis=-1), TOP_K)
    weights = g_top * e_top / jnp.sum(e_top, axis=-1, keepdims=True)
    expert = g_idx * EXPERTS_PER_GROUP + e_idx
    NA = NT * TOP_K
    a_exp = expert.reshape(-1).astype(jnp.int32)
    a_tok = jnp.repeat(jnp.arange(NT, dtype=jnp.int32), TOP_K)
    a_w = weights.reshape(-1)
    order = jnp.argsort(a_exp)
    s_exp = a_exp[order]
    counts = jax.ops.segment_sum(jnp.ones((NA,), jnp.int32), a_exp, num_segments=N_EXPERTS)
    starts = jnp.cumsum(counts) - counts
    padded = (counts + MOE_BLOCK - 1) // MOE_BLOCK * MOE_BLOCK
    pad_ends = jnp.cumsum(padded)
    pad_starts = pad_ends - padded
    dest = pad_starts[s_exp] + jnp.arange(NA, dtype=jnp.int32) - starts[s_exp]
    n_blocks = -(-NA // MOE_BLOCK) + N_EXPERTS
    n_slots = n_blocks * MOE_BLOCK
    slot_tok = jnp.zeros((n_slots,), jnp.int32).at[dest].set(a_tok[order])
    slot_w = jnp.zeros((n_slots,), f32).at[dest].set(a_w[order])
    block_exp = jnp.minimum(jnp.searchsorted(pad_ends, jnp.arange(n_blocks, dtype=jnp.int32) * MOE_BLOCK,
                                             side='right'), N_EXPERTS - 1)
    xb = x[slot_tok].reshape(n_blocks, MOE_BLOCK, D)

    def expert_block(args):
        xs, e = args
        gate, up = jnp.split(xs @ w_e_in[e], 2, axis=-1)
        return (jax.nn.silu(gate) * up) @ w_e_out[e]

    yb = lax.map(expert_block, (xb, block_exp)).reshape(n_slots, D)
    y = jnp.zeros((NT, D), f32).at[slot_tok].add(yb.astype(f32) * slot_w[:, None])
    return y.reshape(Bsz, T, D).astype(h.dtype)


def setup_inputs(seed: int = 0) -> dict:
    key = jax.random.key(seed)
    k = jax.random.split(key, 36)
    L, D = DEPTH, D_MODEL
    f32 = jnp.float32
    nrm = lambda kk, shape, std: std * jax.random.normal(kk, shape, f32)
    uni = lambda kk, shape, lo, hi: jax.random.uniform(kk, shape, f32, minval=lo, maxval=hi)
    ada_offset = jnp.array([0.0, 0.0, ADA_GATE_INIT, 0.0, 0.0, ADA_GATE_INIT], f32)[None, :, None]
    return {
        'x': nrm(k[0], (BATCH, SEQ, D), 1.0),
        'c': nrm(k[1], (BATCH, D), 1.0),
        'w_ada': nrm(k[2], (L, D, 6 * D), 0.1 * D ** -0.5),
        'b_ada': (nrm(k[3], (L, 6, D), 0.02) + ada_offset).reshape(L, 6 * D),
        'norm1_g': 1.0 + nrm(k[4], (L, D), 0.02),
        'norm2_g': 1.0 + nrm(k[5], (L, D), 0.02),
        'w_in': nrm(k[6], (L, D, N_IN), D ** -0.5),
        'mu_a': uni(k[7], (L, A_SHIFT_WIDTH), 0.0, 1.0),
        'w0_a': uni(k[8], (L, A_WIDTH), -6.0, 1.0),
        'w2_a': nrm(k[9], (L, A_DECAY_LORA, A_WIDTH), 0.1),
        'a0_a': nrm(k[10], (L, A_WIDTH), 0.5),
        'a2_a': nrm(k[11], (L, A_ICL_LORA, A_WIDTH), 0.5 * A_ICL_LORA ** -0.5),
        'g2_a': nrm(k[12], (L, A_GATE_LORA, A_WIDTH), A_GATE_LORA ** -0.5),
        'kk_a': 0.85 + nrm(k[13], (L, A_WIDTH), 0.1),
        'ka_a': 1.0 + nrm(k[14], (L, A_WIDTH), 0.1),
        'rk_a': nrm(k[15], (L, A_HEADS, A_HEAD_DIM), 0.1),
        'lnx_g_a': 1.0 + nrm(k[16], (L, A_WIDTH), 0.02),
        'lnx_b_a': nrm(k[17], (L, A_WIDTH), 0.02),
        'conv_w_b': nrm(k[18], (L, B_CONV, 2 * B_WIDTH), B_CONV ** -0.5),
        'conv_b_b': nrm(k[19], (L, 2 * B_WIDTH), 0.02),
        'bi_b': nrm(k[20], (L, B_HEADS), 0.1),
        'bf_b': jnp.linspace(3.0, 6.0, B_HEADS, dtype=f32)[None] + nrm(k[21], (L, B_HEADS), 0.1),
        'hn_g_b': 1.0 + nrm(k[22], (L, B_HEADS, B_HEAD_DIM), 0.02),
        'qn_g_c': 1.0 + nrm(k[23], (L, C_HEAD_DIM), 0.02),
        'kn_g_c': 1.0 + nrm(k[24], (L, C_HEAD_DIM), 0.02),
        'sink_c': nrm(k[25], (L, C_Q_HEADS), 0.5),
        'w_br_a': nrm(k[26], (L, A_WIDTH, D), A_WIDTH ** -0.5),
        'w_br_b': nrm(k[27], (L, B_WIDTH, D), B_WIDTH ** -0.5),
        'w_br_c': nrm(k[28], (L, C_WIDTH, D), C_WIDTH ** -0.5),
        'w_out': nrm(k[29], (L, D, D), D ** -0.5),
        'w_rg': nrm(k[30], (L, D, N_GROUPS), D ** -0.5),
        'b_rg': nrm(k[31], (L, N_GROUPS), 0.01),
        'w_re': nrm(k[32], (L, D, N_EXPERTS), D ** -0.5),
        'b_re': nrm(k[33], (L, N_EXPERTS), 0.01),
        'w_e_in': nrm(k[34], (L, N_EXPERTS, D, 2 * D_EXPERT), D ** -0.5),
        'w_e_out': nrm(k[35], (L, N_EXPERTS, D_EXPERT, D), D_EXPERT ** -0.5),
    }


def reference(x, c, w_ada, b_ada, norm1_g, norm2_g, w_in, mu_a, w0_a, w2_a, a0_a, a2_a, g2_a,
              kk_a, ka_a, rk_a, lnx_g_a, lnx_b_a, conv_w_b, conv_b_b, bi_b, bf_b, hn_g_b,
              qn_g_c, kn_g_c, sink_c, w_br_a, w_br_b, w_br_c, w_out, w_rg, b_rg, w_re, b_re,
              w_e_in, w_e_out):
    cond = jax.nn.silu(c)
    for l in range(DEPTH):
        mod = cond @ w_ada[l] + b_ada[l]
        sh1, sc1, gt1, sh2, sc2, gt2 = jnp.split(mod[:, None, :], 6, axis=-1)
        h = rms_norm(x, norm1_g[l]) * (1 + sc1) + sh1
        y = hybrid_mixer(h, w_in[l], mu_a[l], w0_a[l], w2_a[l], a0_a[l], a2_a[l], g2_a[l],
                         kk_a[l], ka_a[l], rk_a[l], lnx_g_a[l], lnx_b_a[l],
                         conv_w_b[l], conv_b_b[l], bi_b[l], bf_b[l], hn_g_b[l],
                         qn_g_c[l], kn_g_c[l], sink_c[l],
                         w_br_a[l], w_br_b[l], w_br_c[l], w_out[l])
        x = x + gt1 * y
        h = rms_norm(x, norm2_g[l]) * (1 + sc2) + sh2
        x = x + gt2 * hier_moe(h, w_rg[l], b_rg[l], w_re[l], b_re[l], w_e_in[l], w_e_out[l])
    return x
```

```cpp
#include <hip/hip_runtime.h>
#include <cstdio>
#include <cstdint>

#define GAS __attribute__((address_space(1)))
#define LAS __attribute__((address_space(3)))
typedef unsigned short bf16;
typedef short bf16x8 __attribute__((ext_vector_type(8)));
typedef short s16x4 __attribute__((ext_vector_type(4)));
typedef float f32x4 __attribute__((ext_vector_type(4)));
typedef float f32x2 __attribute__((ext_vector_type(2)));
typedef unsigned u32x4 __attribute__((ext_vector_type(4)));
typedef unsigned u32x2 __attribute__((ext_vector_type(2)));
typedef __bf16 bf16x2_t __attribute__((ext_vector_type(2)));

constexpr int D = 1024, BATCH = 8, SEQ = 2048, DEPTH = 4, NT = BATCH * SEQ;
constexpr int NIN = 5896, NINP = 6144;
constexpr int NEXP = 32, DEXP = 512;
constexpr float F8S_EIN = 32.f, F8S_EOUT = 16.f, F8S_WIN = 32.f;
constexpr int PC_QB = 1024, PC_KB = 1280, PC_VB = 1536, PC_OB = 1792, PC_QC = 2048, PC_KC = 2560, PC_VC = 2688, PC_IB = 2816, PC_FB = 2820, PC_GATE = 3072;
constexpr int NPH_LAYER = 10;
constexpr int NPHASES = 1 + DEPTH * NPH_LAYER + 1;

constexpr size_t MiB = 1u << 20;
constexpr size_t WS_CTL = 0, CTL_ZERO_BYTES = 1 * MiB;
constexpr size_t WS_MOD = 1 * MiB;
constexpr size_t WS_WTIN = 2 * MiB;
constexpr size_t WS_WTBR = 50 * MiB;
constexpr size_t WS_WTOUT = 58 * MiB;
constexpr size_t WS_WTEIN = 66 * MiB;
constexpr size_t WS_WTEOUT = 322 * MiB;
constexpr size_t WS_XA = 450 * MiB;
constexpr size_t WS_X1 = 514 * MiB;
constexpr size_t WS_H = 578 * MiB;
constexpr size_t WS_P = 610 * MiB;
constexpr size_t WS_RW = 802 * MiB;
constexpr size_t WS_YCAT = 946 * MiB;
constexpr size_t WS_MERGED = 978 * MiB;
constexpr size_t WS_QKB = 1010 * MiB;
constexpr size_t WS_GATES = 1026 * MiB;
constexpr size_t WS_ROUTE = 1027 * MiB;
constexpr size_t WS_CNTT = 1027 * MiB + 512 * 1024;
constexpr size_t WS_LIST = 1028 * MiB;
constexpr size_t WS_ACT = 1030 * MiB;
constexpr size_t WS_YB = 1072 * MiB;
constexpr size_t WS_LORA = 1154 * MiB;
constexpr size_t WS_WRT = 1155 * MiB;
constexpr size_t WS_PT = 1156 * MiB;
constexpr size_t WS_UT = 1210 * MiB + 320 * MiB;
constexpr size_t WS_ZB = 1168 * MiB;
constexpr size_t WS_YL = 1176 * MiB;
constexpr size_t WS_MSUM = 1192 * MiB;
constexpr size_t WS_MST = 1201 * MiB;
constexpr size_t WS_RWS = 1210 * MiB;
constexpr size_t WS_WTIN8 = 1546 * MiB;
constexpr size_t WS_H8 = 1558 * MiB;
constexpr size_t WS_END = 1574 * MiB;
constexpr int RW_W = 0, RW_K = 1, RW_AV = 2, RW_BV = 3, RW_R = 4, RW_V = 5, RW_G = 6, RW_BONUS = 7, RW_Y = 8;
constexpr size_t RW_STRIDE = (size_t)NT * 256;
constexpr int CW_BAR = 4096;
constexpr int CW_CNT = 16384;
constexpr int LDS_BYTES = 155648;
constexpr int LDS_MISC = 155648 - 256;

__device__ __forceinline__ float bf2f(unsigned v) { return __uint_as_float(v << 16); }
__device__ __forceinline__ unsigned pk2(float lo, float hi) { f32x2 v = {lo, hi}; bf16x2_t b = __builtin_convertvector(v, bf16x2_t); return __builtin_bit_cast(unsigned, b); }
__device__ __forceinline__ float bflo(unsigned w) { return __uint_as_float(w << 16); }
__device__ __forceinline__ float bfhi(unsigned w) { return __uint_as_float(w & 0xffff0000u); }
__device__ __forceinline__ float sigmoidf_(float x) { return 1.0f / (1.0f + __expf(-x)); }
template <int CTRL> __device__ __forceinline__ float dpp_f(float x) { return __builtin_bit_cast(float, __builtin_amdgcn_update_dpp(0, __builtin_bit_cast(int, x), CTRL, 0xf, 0xf, false)); }
__device__ __forceinline__ float row16_sum(float x) {
    x += dpp_f<0xB1>(x);
    x += dpp_f<0x4E>(x);
    x += dpp_f<0x124>(x);
    x += dpp_f<0x128>(x);
    return x;
}
__device__ __forceinline__ int opaque_s(int k) { asm volatile("" : "+s"(k)); return k; }
__device__ __forceinline__ unsigned char* opaque_p(unsigned char* p) { asm volatile("" : "+s"(p)); return p; }
__device__ __forceinline__ float wave_sum(float v) {
    v = row16_sum(v);
    const float s0 = __builtin_bit_cast(float, __builtin_amdgcn_readlane(__builtin_bit_cast(int, v), 0)), s1 = __builtin_bit_cast(float, __builtin_amdgcn_readlane(__builtin_bit_cast(int, v), 16));
    const float s2 = __builtin_bit_cast(float, __builtin_amdgcn_readlane(__builtin_bit_cast(int, v), 32)), s3 = __builtin_bit_cast(float, __builtin_amdgcn_readlane(__builtin_bit_cast(int, v), 48));
    return (s0 + s1) + (s2 + s3);
}
__device__ __forceinline__ float shx(float x, int lane, int m) { return __builtin_bit_cast(float, __builtin_amdgcn_ds_bpermute((lane ^ m) << 2, __builtin_bit_cast(int, x))); }
__device__ __forceinline__ float shup(float x, int lane, int o) { return __builtin_bit_cast(float, __builtin_amdgcn_ds_bpermute((lane >= o ? lane - o : lane) << 2, __builtin_bit_cast(int, x))); }
typedef int v8i32 __attribute__((ext_vector_type(8)));
__device__ __forceinline__ unsigned pk4_fp8(float a, float b, float c, float d) { int p = __builtin_amdgcn_cvt_pk_fp8_f32(a, b, 0, false); p = __builtin_amdgcn_cvt_pk_fp8_f32(c, d, p, true); return (unsigned)p; }
__device__ __forceinline__ f32x4 zero4() { float z; asm volatile("v_mov_b32 %0, 0" : "=v"(z)); return (f32x4){z, z, z, z}; }
__device__ __forceinline__ u32x4 keep4(bool c, u32x4 v) { return (u32x4){c ? v.x : 0u, c ? v.y : 0u, c ? v.z : 0u, c ? v.w : 0u}; }
__device__ __forceinline__ u32x2 keep2(bool c, u32x2 v) { return (u32x2){c ? v.x : 0u, c ? v.y : 0u}; }
#define LDS_WAIT() asm volatile("s_waitcnt lgkmcnt(0)" ::: "memory")
#define VM_WAIT() asm volatile("s_waitcnt vmcnt(0)" ::: "memory")

#define XB_TMO      128
#define XB_XCNT(j)  (256  + 64 * (j))
#define XB_XSUB(j)  (1280 + 64 * (j))
#define XB_XGEN(j)  (2304 + 64 * (j))
#define XB_TOP      3328
#define XB_TOPGEN   3392
#define XCD_BAR_WORDS 3456
#define XB_SPIN_CAP (1u << 18)
__device__ __forceinline__ unsigned xb_ld(unsigned* p)              { return __hip_atomic_load(p, __ATOMIC_RELAXED, __HIP_MEMORY_SCOPE_AGENT); }
__device__ __forceinline__ unsigned xb_add(unsigned* p, unsigned v) { return __hip_atomic_fetch_add(p, v, __ATOMIC_RELAXED, __HIP_MEMORY_SCOPE_AGENT); }
__device__ __forceinline__ unsigned xb_xcc_id() { return (unsigned)__builtin_amdgcn_s_getreg((3 << 11) | 20) & 0xFu; }
#define XB_SPIN(cond, bar) do { unsigned _sp = 0; while (cond) { __builtin_amdgcn_s_sleep(1); \
    if ((++_sp & 255u) == 0u) { if (xb_ld(&(bar)[XB_TMO])) break; if (_sp > XB_SPIN_CAP) { atomicAdd(&(bar)[XB_TMO], 1u); break; } } } } while (0)
struct XcdBarrier { unsigned* bar; unsigned x; volatile LAS unsigned* st; };
__device__ __forceinline__ XcdBarrier xcd_barrier_post(unsigned* bar, volatile LAS unsigned* st, int tid) {
    XcdBarrier b; b.bar = bar; b.x = xb_xcc_id(); b.st = st;
    if (tid == 0) (void)xb_add(&bar[XB_XCNT(b.x)], 1u);
    return b;
}
__device__ __forceinline__ void xcd_barrier_complete(unsigned* bar, unsigned x, unsigned& nloc, unsigned& nx) {
    const unsigned G = gridDim.x * gridDim.y * gridDim.z;
    unsigned sum, cnt, mine, sp = 0u;
    for (;;) {
        sum = 0u; cnt = 0u; mine = 0u;
#pragma unroll
        for (unsigned j = 0; j < 16; ++j) { const unsigned c = xb_ld(&bar[XB_XCNT(j)]); sum += c; cnt += (c > 0u) ? 1u : 0u; mine = (j == x) ? c : mine; }
        if (sum == G) break;
        __builtin_amdgcn_s_sleep(1);
        if ((++sp & 255u) == 0u) { if (xb_ld(&bar[XB_TMO])) break; if (sp > XB_SPIN_CAP) { atomicAdd(&bar[XB_TMO], 1u); break; } }
    }
    nloc = mine > 0u ? mine : 1u; nx = cnt > 0u ? cnt : 1u;
}
__device__ __forceinline__ void xcd_barrier(const XcdBarrier& b, int tid) {
    asm volatile("s_waitcnt vmcnt(0)" ::: "memory");
    __syncthreads();
    if (tid == 0) {
        unsigned* bar = b.bar;
        __builtin_amdgcn_s_waitcnt(0);
        unsigned nloc = b.st[0], nx = b.st[1];
        if (nloc == 0u) { xcd_barrier_complete(bar, b.x, nloc, nx); b.st[0] = nloc; b.st[1] = nx; }
        const unsigned old = xb_add(&bar[XB_XSUB(b.x)], 1u);
        const unsigned gen = old / nloc;
        if (old + 1u == (gen + 1u) * nloc) {
            __builtin_amdgcn_fence(__ATOMIC_RELEASE, "agent");
            asm volatile("s_waitcnt vmcnt(0)" ::: "memory");
            const unsigned og = xb_add(&bar[XB_TOP], 1u);
            const unsigned tg = og / nx;
            if (og + 1u == (tg + 1u) * nx) xb_add(&bar[XB_TOPGEN], 1u);
            else XB_SPIN(xb_ld(&bar[XB_TOPGEN]) == tg, bar);
            __builtin_amdgcn_fence(__ATOMIC_ACQUIRE, "agent");
            xb_add(&bar[XB_XGEN(b.x)], 1u);
            asm volatile("s_waitcnt vmcnt(0)" ::: "memory");
        } else {
            XB_SPIN(xb_ld(&bar[XB_XGEN(b.x)]) == gen, bar);
            __builtin_amdgcn_fence(__ATOMIC_ACQUIRE, "agent");
            asm volatile("s_waitcnt vmcnt(0)" ::: "memory");
        }
    }
    __syncthreads();
}

namespace pg8 {
constexpr int BM = 256, BK = 64, HALF = 128, HTB = HALF * BK * 2, STAGE_BYTES = 8 * HTB, NXCD = 8, WGM = 8;
__host__ __device__ __forceinline__ int lds_byte(int r, int c) { const int st = (r >> 4) * 2 + (c >> 5), rr = r & 15, cc = c & 31, ob = rr * 64 + cc * 2; return st * 1024 + (ob ^ (((ob >> 9) & 1) << 5)); }
__host__ __device__ __forceinline__ void stage_rc(int b, int& R, int& C) { const int st = b / 1024, sb = b % 1024, swz = sb ^ (((sb >> 9) & 1) << 5); R = (st >> 1) * 16 + swz / 64; C = (st & 1) * 32 + (swz % 64) / 2; }
__host__ __device__ __forceinline__ int perm32(int rho) { const int n = rho >> 4, i = rho & 15; return 8 * (i >> 2) + 4 * n + (i & 3); }

struct u32x4x2 { u32x4 a, b; };
struct Unit { int a0, b0, k0, nk, pm, pn, aux, cnt; };
struct Gemm { const GAS bf16* A; const GAS bf16* Bt; int lda, ldb; const GAS int* list; };

__device__ __forceinline__ void tile_of(int L, int nM, int nN, int& pm, int& pn) {
    const int nwg = nM * nN; int wgid = L;
    { const int q = nwg / NXCD, r = nwg % NXCD, xcd = wgid % NXCD, off = wgid / NXCD; wgid = (xcd < r ? xcd * (q + 1) : r * (q + 1) + (xcd - r) * q) + off; }
    const int nig = WGM * nN, gid = wgid / nig, fm = gid * WGM, gsz = (nM - fm) < WGM ? (nM - fm) : WGM;
    pm = fm + ((wgid % nig) % gsz); pn = (wgid % nig) / gsz;
}
struct SchedPlain {
    int nM, nN, nk, G, c;
    __device__ __forceinline__ bool next(int i, Unit& u) const {
        const long L = (long)i * G + c; if (L >= (long)nM * nN) return false;
        tile_of((int)L, nM, nN, u.pm, u.pn); u.a0 = u.pm * BM; u.b0 = u.pn * BM; u.k0 = 0; u.nk = nk; u.aux = 0; u.cnt = BM; return true;
    }
};
struct SchedMerge {
    int G, c, s0, ns, prev0;
    __device__ __forceinline__ bool next(int i, Unit& u) const {
        const int j = i / ns, seg = s0 + (i - ns * j); const long L = (long)j * G + c; if (L >= 256) return false;
        tile_of((int)L, 64, 4, u.pm, u.pn); u.a0 = u.pm * BM; u.b0 = u.pn * BM; u.k0 = seg == 0 ? 0 : (seg == 1 ? 256 : 512); u.nk = seg == 2 ? 8 : 4; u.aux = seg | ((prev0 || seg != s0) ? 16 : 0); u.cnt = BM; return true;
    }
    __device__ __forceinline__ void ready(const Unit&, int) const {}
};
struct SchedMoE {
    const LAS int* tp;
    int G, c, nk, gather;
    __device__ __forceinline__ bool next(int i, Unit& u) const {
        const int cv = (G % 8 == 0) ? (c % 8) * (G / 8) + c / 8 : c;
        const long L = (long)i * G + cv; const int TT = tp[32]; if (L >= (long)TT * 4) return false;
        const int rt = (int)(L >> 2), pn = (int)(L & 3); const int e = (int)((const LAS unsigned char*)(tp + 72))[rt];
        const int tile = rt - tp[e], cn = tp[33 + e] - tile * BM;
        u.pm = rt; u.pn = pn; u.a0 = gather ? (e * NT + tile * BM) : rt * BM; u.b0 = e * 1024 + pn * BM; u.k0 = 0; u.nk = nk; u.aux = e; u.cnt = cn < BM ? cn : BM; return true;
    }
};

#define PG8_MFMA(a, b, c) __builtin_amdgcn_mfma_f32_16x16x32_bf16(a, b, c, 0, 0, 0)

template <class Epi, class Sched, bool GATHER>
__device__ __forceinline__ void gemm_simple(int tid_in, const Gemm g, const Sched& S, const Epi& E) {
    int tid_ = tid_in; asm volatile("" : "+v"(tid_));
    const int tid = tid_, wid = __builtin_amdgcn_readfirstlane(tid >> 6), lane = tid & 63, wr = wid >> 2, wc = wid & 3, fr = lane & 15, fq = lane >> 4;
    for (int ui = 0;; ++ui) {
        Unit u; if (!S.next(ui, u)) break;
        f32x4 acc[2][2][4][2];
#pragma unroll
        for (int a = 0; a < 2; ++a)
#pragma unroll
            for (int b = 0; b < 2; ++b)
#pragma unroll
                for (int m = 0; m < 4; ++m)
#pragma unroll
                    for (int n = 0; n < 2; ++n) acc[a][b][m][n] = zero4();
        const GAS bf16* ap[2][4]; const GAS bf16* bp[2][2];
#pragma unroll
        for (int ai = 0; ai < 2; ++ai)
#pragma unroll
            for (int m = 0; m < 4; ++m) { const int r = ai * HALF + wr * 64 + m * 16 + fr; int row;
                if (GATHER) row = (r < u.cnt) ? g.list[u.a0 + r] : 0; else row = u.a0 + r;
                ap[ai][m] = g.A + (size_t)row * g.lda + u.k0 + 8 * fq; }
#pragma unroll
        for (int bj = 0; bj < 2; ++bj)
#pragma unroll
            for (int n = 0; n < 2; ++n) { const int rho = 16 * n + fr; const int row = u.b0 + bj * HALF + wc * 32 + (Epi::PERM ? perm32(rho) : rho);
                bp[bj][n] = g.Bt + (size_t)row * g.ldb + u.k0 + 8 * fq; }
        for (int kk = 0; kk < u.nk * BK; kk += 32) {
            bf16x8 Bf[2][2];
#pragma unroll
            for (int bj = 0; bj < 2; ++bj)
#pragma unroll
                for (int n = 0; n < 2; ++n) Bf[bj][n] = *(const GAS bf16x8*)(bp[bj][n] + kk);
#pragma unroll
            for (int ai = 0; ai < 2; ++ai) {
                bf16x8 Af[4];
#pragma unroll
                for (int m = 0; m < 4; ++m) Af[m] = *(const GAS bf16x8*)(ap[ai][m] + kk);
#pragma unroll
                for (int bj = 0; bj < 2; ++bj)
#pragma unroll
                    for (int m = 0; m < 4; ++m)
#pragma unroll
                        for (int n = 0; n < 2; ++n) acc[ai][bj][m][n] = PG8_MFMA(Bf[bj][n], Af[m], acc[ai][bj][m][n]);
            }
        }
        E(acc, u, wr, wc, fr, fq);
    }
}

template <class Epi, class Sched, bool GATHER, int ES = 2>
__device__ __forceinline__ void gemm_phase(int tid_in, LAS unsigned char* lds, const Gemm g, const Sched& S, const Epi& E) {
    int tid_ = tid_in; asm volatile("" : "+v"(tid_));
    const int tid = tid_, wid = __builtin_amdgcn_readfirstlane(tid >> 6), lane = tid & 63, wr = wid >> 2, wc = wid & 3, fr = lane & 15, fq = lane >> 4;
    unsigned voffA[2], voffB[2]; const unsigned lda2 = (unsigned)g.lda * (unsigned)ES;
#pragma unroll
    for (int i = 0; i < 2; ++i) { int R, C; stage_rc(tid * 16 + i * 8192, R, C); const int Rb = Epi::PERM ? ((R & ~31) + perm32(R & 31)) : R;
        voffA[i] = GATHER ? (unsigned)C * 2u : (unsigned)(R * g.lda * ES + C * 2); voffB[i] = (unsigned)(Rb * g.ldb * ES + C * 2); }
    const size_t kstep = (size_t)(BK * 2);
    const size_t hstepA = (size_t)HALF * g.lda * ES, hstepB = (size_t)HALF * g.ldb * ES;
    const unsigned ldsw = (unsigned)wid * 1024u;
    const int aoff = lds_byte(wr * 64 + fr, fq * (ES == 2 ? 8 : 16)), boff = lds_byte(wc * 32 + fr, fq * (ES == 2 ? 8 : 16));
    constexpr int KFS = ES == 2 ? 1024 : 16;
#define PG8_SA(b, h) (((b) * 2 + (h)) * HTB)
#define PG8_SB(b, h) ((4 + (b) * 2 + (h)) * HTB)
#define PG8_STAGE2(bufoff, p0, p1) do { \
        __builtin_amdgcn_global_load_lds((const GAS unsigned*)(p0), (LAS unsigned*)(lds + (bufoff) + ldsw), 16, 0, 0); \
        __builtin_amdgcn_global_load_lds((const GAS unsigned*)(p1), (LAS unsigned*)(lds + (bufoff) + ldsw + 8192), 16, 0, 0); } while (0)
#define PG8_STAGE_B(b, h, base) PG8_STAGE2(PG8_SB(b, h), (base) + (h) * hstepB + voffB[0], (base) + (h) * hstepB + voffB[1])
#define PG8_STAGE_A(b, h, base, TK) PG8_STAGE2(PG8_SA(b, h), (base) + (GATHER ? (size_t)(((TK[0] >> (16 * (h))) & 0xffffu) * lda2 + voffA[0]) : (h) * hstepA + voffA[0]), (base) + (GATHER ? (size_t)(((TK[1] >> (16 * (h))) & 0xffffu) * lda2 + voffA[1]) : (h) * hstepA + voffA[1]))
#define PG8_LDA(dst, b, h) do { _Pragma("unroll") for (int m = 0; m < 4; ++m) _Pragma("unroll") for (int k = 0; k < 2; ++k) dst[m][k] = *(const LAS bf16x8*)(lds + PG8_SA(b, h) + aoff + m * 2048 + k * KFS); } while (0)
#define PG8_LDB(dst, b, h) do { _Pragma("unroll") for (int n = 0; n < 2; ++n) _Pragma("unroll") for (int k = 0; k < 2; ++k) dst[n][k] = *(const LAS bf16x8*)(lds + PG8_SB(b, h) + boff + n * 2048 + k * KFS); } while (0)
#define PG8_F8(x) __builtin_bit_cast(v8i32, (u32x4x2){__builtin_bit_cast(u32x4, x[0]), __builtin_bit_cast(u32x4, x[1])})
#define PG8_MMA(ai, bj, At, Bt) do { __builtin_amdgcn_s_setprio(1); _Pragma("unroll") for (int m = 0; m < 4; ++m) _Pragma("unroll") for (int n = 0; n < 2; ++n) { \
        if (ES == 2) { _Pragma("unroll") for (int k = 0; k < 2; ++k) acc[ai][bj][m][n] = __builtin_amdgcn_mfma_f32_16x16x32_bf16(Bt[n][k], At[m][k], acc[ai][bj][m][n], 0, 0, 0); } \
        else { const v8i32 b8_ = PG8_F8(Bt[n]), a8_ = PG8_F8(At[m]); asm volatile("v_mfma_f32_16x16x128_f8f6f4 %0, %1, %2, %0" : "+v"(acc[ai][bj][m][n]) : "v"(b8_), "v"(a8_)); } } \
        __builtin_amdgcn_s_setprio(0); } while (0)
#define PG8_WAIT_V(n) asm volatile("s_waitcnt vmcnt(" #n ")" ::: "memory")
#define PG8_WAIT_L(n) asm volatile("s_waitcnt lgkmcnt(" #n ")" ::: "memory")
#define PG8_BAR __builtin_amdgcn_s_barrier()
#define PG8_SCHED __builtin_amdgcn_sched_barrier(0)
#define PG8_KBODY(a1, a2, a3, b2, b3, AO1, AO2) do { \
        PG8_LDB(B0, 0, 0); PG8_SCHED; PG8_LDA(At, 0, 0); PG8_HOOK_RD; PG8_STAGE_A(1, 1, a1, AO1); \
        PG8_WAIT_L(8); PG8_BAR; PG8_WAIT_L(0); PG8_HOOK_SEL; PG8_MMA(0, 0, At, B0); PG8_BAR; PG8_SCHED; \
        PG8_LDB(B1, 0, 1); PG8_STAGE_B(0, 0, b2); \
        PG8_BAR; PG8_WAIT_L(0); PG8_MMA(0, 1, At, B1); PG8_BAR; \
        PG8_LDA(At, 0, 1); PG8_STAGE_A(0, 0, a2, AO2); \
        PG8_BAR; PG8_WAIT_L(0); PG8_MMA(1, 0, At, B0); PG8_BAR; PG8_SCHED; \
        PG8_STAGE_B(0, 1, b2); \
        PG8_WAIT_V(6); PG8_BAR; PG8_MMA(1, 1, At, B1); PG8_BAR; \
        PG8_LDB(B0, 1, 0); PG8_SCHED; PG8_LDA(At, 1, 0); PG8_STAGE_A(0, 1, a2, AO2); \
        PG8_WAIT_L(8); PG8_BAR; PG8_WAIT_L(0); PG8_MMA(0, 0, At, B0); PG8_BAR; PG8_SCHED; \
        PG8_LDB(B1, 1, 1); PG8_STAGE_B(1, 0, b3); \
        PG8_BAR; PG8_WAIT_L(0); PG8_MMA(0, 1, At, B1); PG8_BAR; \
        PG8_LDA(At, 1, 1); PG8_STAGE_A(1, 0, a3, AO2); \
        PG8_BAR; PG8_WAIT_L(0); PG8_MMA(1, 0, At, B0); PG8_BAR; PG8_SCHED; \
        PG8_STAGE_B(1, 1, b3); \
        PG8_WAIT_V(6); PG8_BAR; PG8_MMA(1, 1, At, B1); PG8_BAR; } while (0)
#define PG8_GOFF(TK, U) do { int q_[2][2], R_[2]; \
        _Pragma("unroll") for (int i = 0; i < 2; ++i) { int R, C; stage_rc(tid * 16 + i * 8192, R, C); R_[i] = R; q_[i][0] = g.list[(U).a0 + R]; q_[i][1] = g.list[(U).a0 + HALF + R]; }        \
        _Pragma("unroll") for (int i = 0; i < 2; ++i) { const int t0 = (R_[i] < (U).cnt) ? q_[i][0] : 0, t1 = (HALF + R_[i] < (U).cnt) ? q_[i][1] : 0; TK[i] = (unsigned)t0 | ((unsigned)t1 << 16); } } while (0)
    Unit cur, nxt; int ui = 0;
    if (!S.next(0, cur)) return;
    f32x4 acc[2][2][4][2];
#pragma unroll
    for (int a = 0; a < 2; ++a)
#pragma unroll
        for (int b = 0; b < 2; ++b)
#pragma unroll
            for (int m = 0; m < 4; ++m)
#pragma unroll
                for (int n = 0; n < 2; ++n) acc[a][b][m][n] = zero4();
    bf16x8 At[4][2], B0[2][2], B1[2][2];
    unsigned aoC[2] = {0u, 0u};
    LAS unsigned* stash = (LAS unsigned*)(lds + STAGE_BYTES + 1024);
    if (GATHER) PG8_GOFF(aoC, cur);
    const GAS char* cA = (const GAS char*)g.A + (GATHER ? (size_t)cur.k0 * ES : ((size_t)cur.a0 * g.lda + cur.k0) * ES);
    const GAS char* cB = (const GAS char*)g.Bt + ((size_t)cur.b0 * g.ldb + cur.k0) * ES;
    PG8_STAGE_B(0, 0, cB); PG8_STAGE_A(0, 0, cA, aoC); PG8_STAGE_B(0, 1, cB); PG8_STAGE_A(0, 1, cA, aoC);
    if (wr == 1) PG8_BAR;
    PG8_WAIT_V(4); PG8_BAR;
    PG8_STAGE_B(1, 0, cB + kstep); PG8_STAGE_A(1, 0, cA + kstep, aoC); PG8_STAGE_B(1, 1, cB + kstep);
    PG8_WAIT_V(6); PG8_BAR;
    for (;;) {
        const bool has_next = S.next(ui + 1, nxt);
        unsigned aoN[2] = {0u, 0u};
        if (GATHER) { if (has_next) PG8_GOFF(aoN, nxt); else { aoN[0] = aoC[0]; aoN[1] = aoC[1]; } stash[tid] = aoN[0]; stash[512 + tid] = aoN[1]; }
        const GAS char* nA = has_next ? (const GAS char*)g.A + (GATHER ? (size_t)nxt.k0 * ES : ((size_t)nxt.a0 * g.lda + nxt.k0) * ES) : cA;
        const GAS char* nB = has_next ? (const GAS char*)g.Bt + ((size_t)nxt.b0 * g.ldb + nxt.k0) * ES : cB;
        const int nt = cur.nk;
        for (int t = 0; t < nt; t += 2) {
            const bool last = (t == nt - 2);
            const GAS char* a1 = cA + (size_t)(t + 1) * kstep;
            const GAS char* a2 = last ? nA : cA + (size_t)(t + 2) * kstep; const GAS char* b2 = last ? nB : cB + (size_t)(t + 2) * kstep;
            unsigned aoX[2] = {0u, 0u}, rN0 = 0u, rN1 = 0u;
#define PG8_HOOK_RD do { if (GATHER) { rN0 = stash[tid]; rN1 = stash[512 + tid]; } } while (0)
#define PG8_HOOK_SEL do { if (GATHER) { asm volatile("" : "+v"(rN0), "+v"(rN1)); aoX[0] = last ? rN0 : aoC[0]; aoX[1] = last ? rN1 : aoC[1]; } } while (0)
            PG8_KBODY(a1, a2, (a2 + kstep), b2, (b2 + kstep), aoC, aoX);
            if constexpr (Epi::MID) { if (t + 2 == Epi::MID_T) { PG8_SCHED; E.mid(acc, cur, wr, wc, fr, fq); PG8_SCHED; } }
#undef PG8_HOOK_RD
#undef PG8_HOOK_SEL
        }
        if (wr == 0) PG8_BAR;
        if (ES == 1) asm volatile("s_nop 15\n\ts_nop 15\n\ts_nop 15" ::: "memory");
        E(acc, cur, wr, wc, fr, fq);
        if (!has_next) break;
#pragma unroll
        for (int a = 0; a < 2; ++a)
#pragma unroll
            for (int b = 0; b < 2; ++b)
#pragma unroll
                for (int m = 0; m < 4; ++m)
#pragma unroll
                    for (int n = 0; n < 2; ++n) acc[a][b][m][n] = zero4();
        cur = nxt; cA = nA; cB = nB; ++ui;
        if (GATHER) { aoC[0] = stash[tid]; aoC[1] = stash[512 + tid]; }
        if (wr == 1) PG8_BAR;
    }
    PG8_WAIT_V(0);
    PG8_BAR;
#undef PG8_SA
#undef PG8_SB
#undef PG8_STAGE2
#undef PG8_STAGE_A
#undef PG8_STAGE_B
#undef PG8_LDA
#undef PG8_LDB
#undef PG8_MMA
#undef PG8_F8
#undef PG8_WAIT_V
#undef PG8_WAIT_L
#undef PG8_BAR
#undef PG8_SCHED
#undef PG8_KBODY
#undef PG8_GOFF
}
}

namespace pg8 {
struct EpiStoreBf16 {
    static constexpr bool MID = false;
    static constexpr bool PERM = true;
    GAS bf16* O; int ldc; float sc;
    __device__ __forceinline__ void operator()(const f32x4 (&acc)[2][2][4][2], const Unit& u, int wr, int wc, int fr, int fq) const {
        const int row0 = u.pm * BM + wr * 64 + fr, col0 = u.pn * BM + wc * 32 + 8 * fq;
#pragma unroll
        for (int ai = 0; ai < 2; ++ai)
#pragma unroll
            for (int m = 0; m < 4; ++m) { GAS bf16* rowp = O + (size_t)(row0 + ai * HALF + m * 16) * ldc + col0;
#pragma unroll
                for (int bj = 0; bj < 2; ++bj) { const f32x4 v0 = acc[ai][bj][m][0] * sc, v1 = acc[ai][bj][m][1] * sc;
                    u32x4 w; w.x = pk2(v0[0], v0[1]); w.y = pk2(v0[2], v0[3]); w.z = pk2(v1[0], v1[1]); w.w = pk2(v1[2], v1[3]);
                    *(GAS u32x4*)(rowp + bj * HALF) = w; } }
    }
};
struct EpiStoreFp8 {
    static constexpr bool MID = false;
    static constexpr bool PERM = true;
    GAS unsigned char* O; int ldc; float sc;
    __device__ __forceinline__ void operator()(const f32x4 (&acc)[2][2][4][2], const Unit& u, int wr, int wc, int fr, int fq) const {
        const int row0 = u.pm * BM + wr * 64 + fr, col0 = u.pn * BM + wc * 32 + 8 * fq;
#pragma unroll
        for (int ai = 0; ai < 2; ++ai)
#pragma unroll
            for (int m = 0; m < 4; ++m) { GAS unsigned char* rowp = O + (size_t)(row0 + ai * HALF + m * 16) * ldc + col0;
#pragma unroll
                for (int bj = 0; bj < 2; ++bj) { const f32x4 v0 = acc[ai][bj][m][0] * sc, v1 = acc[ai][bj][m][1] * sc;
                    u32x2 w; w.x = pk4_fp8(v0[0], v0[1], v0[2], v0[3]); w.y = pk4_fp8(v1[0], v1[1], v1[2], v1[3]);
                    *(GAS u32x2*)(rowp + bj * HALF) = w; } }
    }
};
struct EpiGateU8 {
    static constexpr bool MID = false;
    static constexpr bool PERM = true;
    GAS unsigned char* O; float sc;
    __device__ __forceinline__ void operator()(const f32x4 (&acc)[2][2][4][2], const Unit& u, int wr, int wc, int fr, int fq) const {
        const int row0 = u.pm * BM + wr * 64 + fr, col0 = u.pn * BM + wc * 32 + 8 * fq;
#pragma unroll
        for (int ai = 0; ai < 2; ++ai)
#pragma unroll
            for (int m = 0; m < 4; ++m) { GAS unsigned char* rowp = O + (size_t)(row0 + ai * HALF + m * 16) * (NINP * 2) + col0;
#pragma unroll
                for (int bj = 0; bj < 2; ++bj) { unsigned q[8];
#pragma unroll
                    for (int n = 0; n < 2; ++n)
#pragma unroll
                        for (int i = 0; i < 4; ++i) q[4 * n + i] = (unsigned)(sigmoidf_(acc[ai][bj][m][n][i] * sc) * 255.f + 0.5f);
                    u32x2 w; w.x = q[0] | (q[1] << 8) | (q[2] << 16) | (q[3] << 24); w.y = q[4] | (q[5] << 8) | (q[6] << 16) | (q[7] << 24);
                    *(GAS u32x2*)(rowp + bj * HALF) = w; } }
    }
};
struct EpiMerge {
    static constexpr bool MID = false;
    static constexpr bool PERM = true;
    GAS bf16* O; const GAS bf16* P;
    __device__ __forceinline__ void operator()(const f32x4 (&acc)[2][2][4][2], const Unit& u, int wr, int wc, int fr, int fq) const {
        const int row0 = u.pm * BM + wr * 64 + fr, col0 = u.pn * BM + wc * 32 + 8 * fq, seg = u.aux & 15; const bool hasprev = (u.aux & 16) != 0;
#pragma unroll
        for (int ai = 0; ai < 2; ++ai) {
            u32x2 gw[4][2]; u32x4 pw[4][2];
#pragma unroll
            for (int m = 0; m < 4; ++m)
#pragma unroll
                for (int bj = 0; bj < 2; ++bj) { const size_t row = (size_t)(row0 + ai * HALF + m * 16); const int col = col0 + bj * HALF;
                    gw[m][bj] = *(const GAS u32x2*)((const GAS unsigned char*)P + row * (NINP * 2) + 2 * PC_GATE + seg * 1024 + col);
                    pw[m][bj] = (u32x4){0u, 0u, 0u, 0u}; if (hasprev) pw[m][bj] = *(const GAS u32x4*)(O + row * 1024 + col); }
#pragma unroll
            for (int m = 0; m < 4; ++m)
#pragma unroll
                for (int bj = 0; bj < 2; ++bj) { const size_t row = (size_t)(row0 + ai * HALF + m * 16); const int col = col0 + bj * HALF;
                    const u32x2 g2 = gw[m][bj]; const u32x4 p4 = pw[m][bj]; const f32x4 v0 = acc[ai][bj][m][0] * (1.f / 255.f), v1 = acc[ai][bj][m][1] * (1.f / 255.f);
                    float o[8];
                    o[0] = bflo(p4.x) + (float)(g2.x & 0xffu) * v0[0]; o[1] = bfhi(p4.x) + (float)((g2.x >> 8) & 0xffu) * v0[1];
                    o[2] = bflo(p4.y) + (float)((g2.x >> 16) & 0xffu) * v0[2]; o[3] = bfhi(p4.y) + (float)(g2.x >> 24) * v0[3];
                    o[4] = bflo(p4.z) + (float)(g2.y & 0xffu) * v1[0]; o[5] = bfhi(p4.z) + (float)((g2.y >> 8) & 0xffu) * v1[1];
                    o[6] = bflo(p4.w) + (float)((g2.y >> 16) & 0xffu) * v1[2]; o[7] = bfhi(p4.w) + (float)(g2.y >> 24) * v1[3];
                    u32x4 w; w.x = pk2(o[0], o[1]); w.y = pk2(o[2], o[3]); w.z = pk2(o[4], o[5]); w.w = pk2(o[6], o[7]);
                    *(GAS u32x4*)(O + row * 1024 + col) = w; }
        }
    }
};
struct SchedMergeAB {
    int G, c;
    __device__ __forceinline__ bool next(int i, Unit& u) const {
        const long L = (long)i * G + c; if (L >= 256) return false;
        tile_of((int)L, 64, 4, u.pm, u.pn); u.a0 = u.pm * BM; u.b0 = u.pn * BM; u.k0 = 0; u.nk = 8; u.aux = 1 | 16; u.cnt = BM; return true;
    }
    __device__ __forceinline__ void ready(const Unit&, int) const {}
};
struct EpiMergeAB {
    static constexpr bool PERM = true;
    static constexpr bool MID = true; static constexpr int MID_T = 4;
    GAS bf16* O; const GAS bf16* P;
    static __device__ __forceinline__ float gq(unsigned w, int k) { return fmaxf((float)((w >> (8 * k)) & 0xffu), 0.5f); }
    __device__ __forceinline__ void mid(f32x4 (&acc)[2][2][4][2], const Unit& u, int wr, int wc, int fr, int fq) const {
        unsigned rowq = (unsigned)(u.pm * BM + wr * 64 + fr), colq = (unsigned)(2 * PC_GATE + u.pn * BM + wc * 32 + 8 * fq); asm volatile("" : "+v"(rowq), "+v"(colq));
        const GAS unsigned char* gp0 = (const GAS unsigned char*)P + (size_t)rowq * (NINP * 2) + colq;
        u32x2 ga[2][2], gb[2][2];
#define MAB_LOAD(buf, idx) do { const GAS unsigned char* gp = gp0 + (size_t)(((idx) >> 2) * HALF + ((idx) & 3) * 16) * (NINP * 2); \
            ga[buf][0] = *(const GAS u32x2*)gp; gb[buf][0] = *(const GAS u32x2*)(gp + 1024); ga[buf][1] = *(const GAS u32x2*)(gp + HALF); gb[buf][1] = *(const GAS u32x2*)(gp + HALF + 1024); } while (0)
        MAB_LOAD(0, 0);
#pragma unroll
        for (int idx = 0; idx < 8; ++idx) {
            if (idx + 1 < 8) MAB_LOAD((idx + 1) & 1, idx + 1);
            __builtin_amdgcn_sched_barrier(0);
#pragma unroll
            for (int bj = 0; bj < 2; ++bj) { const u32x2 a2 = ga[idx & 1][bj], b2 = gb[idx & 1][bj];
#pragma unroll
                for (int e = 0; e < 4; ++e) { acc[idx >> 2][bj][idx & 3][0][e] *= gq(a2.x, e) * __builtin_amdgcn_rcpf(gq(b2.x, e)); acc[idx >> 2][bj][idx & 3][1][e] *= gq(a2.y, e) * __builtin_amdgcn_rcpf(gq(b2.y, e)); } }
            __builtin_amdgcn_sched_barrier(0);
        }
#undef MAB_LOAD
    }
    __device__ __forceinline__ void operator()(const f32x4 (&acc)[2][2][4][2], const Unit& u, int wr, int wc, int fr, int fq) const {
        const int row0 = u.pm * BM + wr * 64 + fr, col0 = u.pn * BM + wc * 32 + 8 * fq;
#pragma unroll
        for (int ai = 0; ai < 2; ++ai) {
            u32x2 gw[4][2]; u32x4 pw[4][2];
#pragma unroll
            for (int m = 0; m < 4; ++m)
#pragma unroll
                for (int bj = 0; bj < 2; ++bj) { const size_t row = (size_t)(row0 + ai * HALF + m * 16); const int col = col0 + bj * HALF;
                    gw[m][bj] = *(const GAS u32x2*)((const GAS unsigned char*)P + row * (NINP * 2) + 2 * PC_GATE + 1024 + col);
                    pw[m][bj] = *(const GAS u32x4*)(O + row * 1024 + col); }
#pragma unroll
            for (int m = 0; m < 4; ++m)
#pragma unroll
                for (int bj = 0; bj < 2; ++bj) { const size_t row = (size_t)(row0 + ai * HALF + m * 16); const int col = col0 + bj * HALF;
                    const u32x2 g2 = gw[m][bj]; const u32x4 p4 = pw[m][bj]; const f32x4 v0 = acc[ai][bj][m][0] * (1.f / 255.f), v1 = acc[ai][bj][m][1] * (1.f / 255.f);
                    float o[8];
                    o[0] = bflo(p4.x) + gq(g2.x, 0) * v0[0]; o[1] = bfhi(p4.x) + gq(g2.x, 1) * v0[1]; o[2] = bflo(p4.y) + gq(g2.x, 2) * v0[2]; o[3] = bfhi(p4.y) + gq(g2.x, 3) * v0[3];
                    o[4] = bflo(p4.z) + gq(g2.y, 0) * v1[0]; o[5] = bfhi(p4.z) + gq(g2.y, 1) * v1[1]; o[6] = bflo(p4.w) + gq(g2.y, 2) * v1[2]; o[7] = bfhi(p4.w) + gq(g2.y, 3) * v1[3];
                    u32x4 w; w.x = pk2(o[0], o[1]); w.y = pk2(o[2], o[3]); w.z = pk2(o[4], o[5]); w.w = pk2(o[6], o[7]);
                    *(GAS u32x4*)(O + row * 1024 + col) = w; }
        }
    }
};
struct EpiRes {
    static constexpr bool MID = false;
    static constexpr bool PERM = true;
    const GAS float* xres32; const GAS bf16* xres16; GAS bf16* X1; const GAS float* gt;
    __device__ __forceinline__ void operator()(const f32x4 (&acc)[2][2][4][2], const Unit& u, int wr, int wc, int fr, int fq) const {
        const int row0 = u.pm * BM + wr * 64 + fr, col0 = u.pn * BM + wc * 32 + 8 * fq;
        const GAS float* gb = gt + (size_t)((u.pm * BM) / SEQ) * 6144 + col0;
        f32x4 gv[2][2];
#pragma unroll
        for (int bj = 0; bj < 2; ++bj)
#pragma unroll
            for (int n = 0; n < 2; ++n) gv[bj][n] = *(const GAS f32x4*)(gb + bj * HALF + 4 * n);
#pragma unroll
        for (int ai = 0; ai < 2; ++ai) {
            if (xres32) {
#pragma unroll
                for (int mh = 0; mh < 2; ++mh) {
                    f32x4 xr[2][2][2];
#pragma unroll
                    for (int m = 0; m < 2; ++m)
#pragma unroll
                        for (int bj = 0; bj < 2; ++bj) { const size_t off = (size_t)(row0 + ai * HALF + (2 * mh + m) * 16) * 1024 + col0 + bj * HALF;
                            xr[m][bj][0] = *(const GAS f32x4*)(xres32 + off); xr[m][bj][1] = *(const GAS f32x4*)(xres32 + off + 4); }
#pragma unroll
                    for (int m = 0; m < 2; ++m)
#pragma unroll
                        for (int bj = 0; bj < 2; ++bj) { const size_t off = (size_t)(row0 + ai * HALF + (2 * mh + m) * 16) * 1024 + col0 + bj * HALF;
                            const f32x4 o0 = xr[m][bj][0] + gv[bj][0] * acc[ai][bj][2 * mh + m][0], o1 = xr[m][bj][1] + gv[bj][1] * acc[ai][bj][2 * mh + m][1];
                            u32x4 w; w.x = pk2(o0[0], o0[1]); w.y = pk2(o0[2], o0[3]); w.z = pk2(o1[0], o1[1]); w.w = pk2(o1[2], o1[3]);
                            *(GAS u32x4*)(X1 + off) = w; } }
            } else {
                u32x4 xw[4][2];
#pragma unroll
                for (int m = 0; m < 4; ++m)
#pragma unroll
                    for (int bj = 0; bj < 2; ++bj) xw[m][bj] = *(const GAS u32x4*)(xres16 + (size_t)(row0 + ai * HALF + m * 16) * 1024 + col0 + bj * HALF);
#pragma unroll
                for (int m = 0; m < 4; ++m)
#pragma unroll
                    for (int bj = 0; bj < 2; ++bj) { const size_t off = (size_t)(row0 + ai * HALF + m * 16) * 1024 + col0 + bj * HALF; const u32x4 w4 = xw[m][bj];
                        const f32x4 x0 = {bflo(w4.x), bfhi(w4.x), bflo(w4.y), bfhi(w4.y)}, x1 = {bflo(w4.z), bfhi(w4.z), bflo(w4.w), bfhi(w4.w)};
                        const f32x4 o0 = x0 + gv[bj][0] * acc[ai][bj][m][0], o1 = x1 + gv[bj][1] * acc[ai][bj][m][1];
                        u32x4 w; w.x = pk2(o0[0], o0[1]); w.y = pk2(o0[2], o0[3]); w.z = pk2(o1[0], o1[1]); w.w = pk2(o1[2], o1[3]);
                        *(GAS u32x4*)(X1 + off) = w; }
            }
        }
    }
};
struct EpiAct {
    static constexpr bool MID = false;
    static constexpr bool PERM = true;
    GAS unsigned char* O; float sc;
    __device__ __forceinline__ void operator()(const f32x4 (&acc)[2][2][4][2], const Unit& u, int wr, int wc, int fr, int fq) const {
        const int row0 = u.pm * BM + wr * 64 + fr, col0 = u.pn * 128 + wc * 32 + 8 * fq;
#pragma unroll
        for (int ai = 0; ai < 2; ++ai)
#pragma unroll
            for (int m = 0; m < 4; ++m) { GAS unsigned char* rowp = O + (size_t)(row0 + ai * HALF + m * 16) * DEXP + col0;
                float o[8];
#pragma unroll
                for (int n = 0; n < 2; ++n)
#pragma unroll
                    for (int i = 0; i < 4; ++i) { const float gt = acc[ai][0][m][n][i] * sc, up = acc[ai][1][m][n][i] * sc; o[4 * n + i] = gt * sigmoidf_(gt) * up; }
                u32x2 w; w.x = pk4_fp8(o[0], o[1], o[2], o[3]); w.y = pk4_fp8(o[4], o[5], o[6], o[7]);
                *(GAS u32x2*)rowp = w; }
    }
};
}

constexpr int NWAVES = 8, NTHR = 512;
struct Args { const float* in[36]; float* out; unsigned char* ws; int ph_lo, ph_hi; };
struct Frame {
    LAS unsigned char* lds;
    int tid, lane, wave, G, bid;
    const float* const* in;
    GAS float* out;
    unsigned char* ws;
};
#define WSP(T, off) ((GAS T*)(opaque_p(F.ws) + (off)))
#define INP(k) ((const GAS float*)F.in[opaque_s(k)])

struct MapId { __device__ __forceinline__ int operator()(int n) const { return n; } };
struct MapWin { __device__ __forceinline__ int operator()(int n) const { return n < 2048 ? n : (n < 2056 ? PC_IB + (n - 2048) : (n < 2824 ? n - 8 : PC_GATE + (n - 2824))); } };
struct MapOff { int off; __device__ __forceinline__ int operator()(int n) const { return n + off; } };
struct MapEin { __device__ __forceinline__ int operator()(int n) const { const int half = n >> 9, j = n & 511; return 256 * (j >> 7) + 128 * half + (j & 127); } };
template <class Map, bool F8>
__device__ __forceinline__ void tr_item(const GAS float* W, int N, GAS bf16* WT, int ldk, int koff, LAS float* scr, int item, int lane, Map map, float f8scale, int f8row = 0, GAS unsigned char* WT8 = nullptr) {
    const int nblk = (N + 63) / 64, kb = item / nblk, nb = item - kb * nblk, k0 = 64 * kb, n0 = 64 * nb;
    const int l15 = lane & 15, l4 = lane >> 4;
    f32x4 v[16];
    const bool ok = (n0 + 4 * l15) < N;
#pragma unroll
    for (int i = 0; i < 16; ++i) v[i] = ok ? *(const GAS f32x4*)(W + (size_t)(k0 + 4 * i + l4) * N + n0 + 4 * l15) : (f32x4){0.f, 0.f, 0.f, 0.f};
#pragma unroll
    for (int i = 0; i < 16; ++i) { LAS float* d = scr + (4 * i + l4) * 65 + 4 * l15; d[0] = v[i][0]; d[1] = v[i][1]; d[2] = v[i][2]; d[3] = v[i][3]; }
    LDS_WAIT(); asm volatile("" ::: "memory");
    const int c = lane & 7;
#pragma unroll
    for (int j = 0; j < 8; ++j) { const int n = (lane >> 3) + 8 * j; const LAS float* s = scr + (8 * c) * 65 + n;
        const int drow = map(n0 + n);
        if (F8 && drow >= f8row) { u32x2 o; o.x = pk4_fp8(s[0 * 65] * f8scale, s[1 * 65] * f8scale, s[2 * 65] * f8scale, s[3 * 65] * f8scale); o.y = pk4_fp8(s[4 * 65] * f8scale, s[5 * 65] * f8scale, s[6 * 65] * f8scale, s[7 * 65] * f8scale);
            if (n0 + n < N) *(GAS u32x2*)((WT8 ? WT8 : (GAS unsigned char*)WT) + (size_t)(drow - f8row) * ldk + koff + k0 + 8 * c) = o; }
        else { u32x4 o; o.x = pk2(s[0 * 65], s[1 * 65]); o.y = pk2(s[2 * 65], s[3 * 65]); o.z = pk2(s[4 * 65], s[5 * 65]); o.w = pk2(s[6 * 65], s[7 * 65]);
            if (n0 + n < N) *(GAS u32x4*)(WT + (size_t)map(n0 + n) * ldk + koff + k0 + 8 * c) = o; } }
    LDS_WAIT(); asm volatile("" ::: "memory");
}
__device__ __forceinline__ void p0_prologue(Frame& F) {
    {
        LAS float* condT = (LAS float*)F.lds;
        LAS float* part = condT + 8192;
        const GAS float* c = INP(1);
        for (int i = F.tid; i < 8192; i += NTHR) { const int b = i >> 10, k = i & 1023; const float x = c[i]; condT[k * 8 + b] = x * sigmoidf_(x); }
        __syncthreads();
        GAS float* mod = WSP(float, WS_MOD);
        for (int it = F.bid; it < DEPTH * 96; it += F.G) {
            const int l = it / 96, n0 = (it - l * 96) * 64;
            const GAS float* w = INP(2) + (size_t)l * 1024 * 6144 + n0 + F.lane;
            float a[8] = {0.f, 0.f, 0.f, 0.f, 0.f, 0.f, 0.f, 0.f};
            const int kb = F.wave * 128;
#pragma unroll 8
            for (int k = 0; k < 128; ++k) { const float wv = w[(size_t)(kb + k) * 6144];
                const f32x4 c0 = *(const LAS f32x4*)(condT + (kb + k) * 8), c1 = *(const LAS f32x4*)(condT + (kb + k) * 8 + 4);
                a[0] += c0[0] * wv; a[1] += c0[1] * wv; a[2] += c0[2] * wv; a[3] += c0[3] * wv; a[4] += c1[0] * wv; a[5] += c1[1] * wv; a[6] += c1[2] * wv; a[7] += c1[3] * wv; }
#pragma unroll
            for (int b = 0; b < 8; ++b) part[(F.wave * 8 + b) * 64 + F.lane] = a[b];
            __syncthreads();
            { const int b = F.tid >> 6, col = F.tid & 63; float s = INP(3)[(size_t)l * 6144 + n0 + col];
#pragma unroll
              for (int w8 = 0; w8 < 8; ++w8) s += part[(w8 * 8 + b) * 64 + col];
              mod[((size_t)l * 8 + b) * 6144 + n0 + col] = s; }
            __syncthreads();
        }
    }
}
constexpr int CV_IN = 16 * 93, CV_BRA = 4 * 16, CV_BRC = 8 * 16, CV_OUT = 16 * 16, CV_EIN1 = 16 * 16, CV_EOUT1 = 8 * 16, CV_LORA = 4 + 4 + 8, CV_RT = 16 + 16;
constexpr int CV_LAYER = CV_IN + 2 * CV_BRA + CV_BRC + CV_OUT + NEXP * CV_EIN1 + NEXP * CV_EOUT1 + CV_LORA + CV_RT, CV_ITEMS = CV_LAYER + 24;
struct MapAny { int kind, off; __device__ __forceinline__ int operator()(int n) const { return kind == 0 ? n + off : (kind == 1 ? MapWin()(n) : MapEin()(n)); } };
__device__ __forceinline__ void convert_item(Frame& F, int l, int it, LAS float* scr) {
    if (it >= CV_LAYER) { const int q = (it - CV_LAYER) * 64 + F.lane; *(GAS u32x4*)(WSP(bf16, WS_WRT) + ((size_t)l * 48 + 36) * 1024 + q * 8) = (u32x4){0u, 0u, 0u, 0u}; return; }
    int r = it, inp, N, ldk, koff = 0, kind = 0, moff = 0; float f8 = 0.f; size_t so, wo, wsb;
    if (r < CV_IN) {
        tr_item<MapAny, true>((const GAS float*)F.in[6] + (size_t)l * 1024 * NIN, NIN, WSP(bf16, WS_WTIN) + (size_t)l * NINP * 1024, 1024, 0, scr, r, F.lane, MapAny{1, 0}, F8S_WIN, PC_GATE, WSP(unsigned char, WS_WTIN8) + (size_t)l * 3072 * 1024); return; }
    if (false) { inp = 6; so = 0; N = NIN; wsb = WS_WTIN; wo = 0; ldk = 1024; kind = 1; }
    else if ((r -= CV_IN) < CV_BRA) { inp = 26; so = (size_t)l * 256 * 1024; N = 1024; wsb = WS_WTBR; wo = (size_t)l * 1024 * 1024; ldk = 1024; }
    else if ((r -= CV_BRA) < CV_BRA) { inp = 27; so = (size_t)l * 256 * 1024; N = 1024; wsb = WS_WTBR; wo = (size_t)l * 1024 * 1024; ldk = 1024; koff = 256; }
    else if ((r -= CV_BRA) < CV_BRC) { inp = 28; so = (size_t)l * 512 * 1024; N = 1024; wsb = WS_WTBR; wo = (size_t)l * 1024 * 1024; ldk = 1024; koff = 512; }
    else if ((r -= CV_BRC) < CV_OUT) { inp = 29; so = (size_t)l * 1024 * 1024; N = 1024; wsb = WS_WTOUT; wo = (size_t)l * 1024 * 1024; ldk = 1024; }
    else if ((r -= CV_OUT) < NEXP * CV_EIN1) { const int e = r / CV_EIN1; r -= e * CV_EIN1; inp = 34; so = ((size_t)l * NEXP + e) * 1024 * 1024; N = 1024; wsb = WS_WTEIN; wo = ((size_t)l * NEXP + e) * 1024 * 1024; ldk = 1024; kind = 2; f8 = F8S_EIN; }
    else if ((r -= NEXP * CV_EIN1) < NEXP * CV_EOUT1) { const int e = r / CV_EOUT1; r -= e * CV_EOUT1; inp = 35; so = ((size_t)l * NEXP + e) * 512 * 1024; N = 1024; wsb = WS_WTEOUT; wo = ((size_t)l * NEXP + e) * 1024 * 512; ldk = 512; f8 = F8S_EOUT; }
    else if ((r -= NEXP * CV_EOUT1) < 4) { inp = 9; so = (size_t)l * 64 * 256; N = 256; wsb = WS_LORA; wo = (size_t)l * 65536; ldk = 64; }
    else if ((r -= 4) < 4) { inp = 11; so = (size_t)l * 64 * 256; N = 256; wsb = WS_LORA; wo = (size_t)l * 65536 + 256 * 64; ldk = 64; }
    else if ((r -= 4) < 8) { inp = 12; so = (size_t)l * 128 * 256; N = 256; wsb = WS_LORA; wo = (size_t)l * 65536 + 2 * 256 * 64; ldk = 128; }
    else if ((r -= 8) < 16) { inp = 30; so = (size_t)l * 1024 * 4; N = 4; wsb = WS_WRT; wo = (size_t)l * 48 * 1024; ldk = 1024; }
    else { r -= 16; inp = 32; so = (size_t)l * 1024 * 32; N = 32; wsb = WS_WRT; wo = (size_t)l * 48 * 1024; ldk = 1024; moff = 4; }
    if (f8 != 0.f) tr_item<MapAny, true>((const GAS float*)F.in[inp] + so, N, (GAS bf16*)(opaque_p(F.ws) + wsb + wo), ldk, koff, scr, r, F.lane, MapAny{kind, moff}, f8);
    else tr_item<MapAny, false>((const GAS float*)F.in[inp] + so, N, (GAS bf16*)(opaque_p(F.ws) + wsb) + wo, ldk, koff, scr, r, F.lane, MapAny{kind, moff}, 1.f);
}
struct CvP { const GAS float* W; GAS bf16* WTb; GAS unsigned char* WT8b; int N, ldk, koff, r, kind, moff, f8row, mode, l; float f8; };
__device__ __forceinline__ CvP convert_params(Frame& F, int l, int it, bool valid) {
    CvP p; p.W = (const GAS float*)F.in[6]; p.WTb = nullptr; p.WT8b = nullptr; p.N = 64; p.ldk = 64; p.koff = 0; p.r = 0; p.kind = 0; p.moff = 0; p.f8row = 0; p.mode = 0; p.l = l; p.f8 = 0.f;
    if (!valid) return p;
    if (it >= CV_LAYER) { p.mode = 1; p.r = it - CV_LAYER; return p; }
    p.mode = 2;
    int r = it, inp, N, ldk, koff = 0, kind = 0, moff = 0; float f8 = 0.f; size_t so, wo, wsb;
    if (r < CV_IN) { p.W = (const GAS float*)F.in[6] + (size_t)l * 1024 * NIN; p.N = NIN; p.WTb = WSP(bf16, WS_WTIN) + (size_t)l * NINP * 1024; p.WT8b = WSP(unsigned char, WS_WTIN8) + (size_t)l * 3072 * 1024;
        p.ldk = 1024; p.r = r; p.kind = 1; p.f8 = F8S_WIN; p.f8row = PC_GATE; return p; }
    if ((r -= CV_IN) < CV_BRA) { inp = 26; so = (size_t)l * 256 * 1024; N = 1024; wsb = WS_WTBR; wo = (size_t)l * 1024 * 1024; ldk = 1024; }
    else if ((r -= CV_BRA) < CV_BRA) { inp = 27; so = (size_t)l * 256 * 1024; N = 1024; wsb = WS_WTBR; wo = (size_t)l * 1024 * 1024; ldk = 1024; koff = 256; }
    else if ((r -= CV_BRA) < CV_BRC) { inp = 28; so = (size_t)l * 512 * 1024; N = 1024; wsb = WS_WTBR; wo = (size_t)l * 1024 * 1024; ldk = 1024; koff = 512; }
    else if ((r -= CV_BRC) < CV_OUT) { inp = 29; so = (size_t)l * 1024 * 1024; N = 1024; wsb = WS_WTOUT; wo = (size_t)l * 1024 * 1024; ldk = 1024; }
    else if ((r -= CV_OUT) < NEXP * CV_EIN1) { const int e = r / CV_EIN1; r -= e * CV_EIN1; inp = 34; so = ((size_t)l * NEXP + e) * 1024 * 1024; N = 1024; wsb = WS_WTEIN; wo = ((size_t)l * NEXP + e) * 1024 * 1024; ldk = 1024; kind = 2; f8 = F8S_EIN; }
    else if ((r -= NEXP * CV_EIN1) < NEXP * CV_EOUT1) { const int e = r / CV_EOUT1; r -= e * CV_EOUT1; inp = 35; so = ((size_t)l * NEXP + e) * 512 * 1024; N = 1024; wsb = WS_WTEOUT; wo = ((size_t)l * NEXP + e) * 1024 * 512; ldk = 512; f8 = F8S_EOUT; }
    else if ((r -= NEXP * CV_EOUT1) < 4) { inp = 9; so = (size_t)l * 64 * 256; N = 256; wsb = WS_LORA; wo = (size_t)l * 65536; ldk = 64; }
    else if ((r -= 4) < 4) { inp = 11; so = (size_t)l * 64 * 256; N = 256; wsb = WS_LORA; wo = (size_t)l * 65536 + 256 * 64; ldk = 64; }
    else if ((r -= 4) < 8) { inp = 12; so = (size_t)l * 128 * 256; N = 256; wsb = WS_LORA; wo = (size_t)l * 65536 + 2 * 256 * 64; ldk = 128; }
    else if ((r -= 8) < 16) { inp = 30; so = (size_t)l * 1024 * 4; N = 4; wsb = WS_WRT; wo = (size_t)l * 48 * 1024; ldk = 1024; }
    else { r -= 16; inp = 32; so = (size_t)l * 1024 * 32; N = 32; wsb = WS_WRT; wo = (size_t)l * 48 * 1024; ldk = 1024; moff = 4; }
    p.W = (const GAS float*)F.in[inp] + so; p.N = N; p.ldk = ldk; p.koff = koff; p.r = r; p.kind = kind; p.moff = moff; p.f8 = f8;
    if (f8 != 0.f) p.WT8b = (GAS unsigned char*)(opaque_p(F.ws) + wsb + wo); else p.WTb = (GAS bf16*)(opaque_p(F.ws) + wsb) + wo;
    return p;
}
__device__ __forceinline__ void tr_load(const CvP& p, int lane, f32x4 (&v)[16]) {
    const int nblk = (p.N + 63) / 64, kb = p.r / nblk, nb = p.r - kb * nblk, k0 = 64 * kb, n0 = 64 * nb;
    const int l15 = lane & 15, l4 = lane >> 4;
    const bool ok = (n0 + 4 * l15) < p.N;
    const GAS float* wp = p.W + (size_t)(k0 + l4) * p.N + (ok ? n0 + 4 * l15 : 0);
#pragma unroll
    for (int i = 0; i < 16; ++i) v[i] = *(const GAS f32x4*)(wp + (size_t)(4 * i) * p.N);
}
__device__ __forceinline__ void tr_finish(Frame& F, const CvP& p, int lane, LAS float* scr, const f32x4 (&v)[16]) {
    if (p.mode == 1) { const int q = p.r * 64 + lane; *(GAS u32x4*)(WSP(bf16, WS_WRT) + ((size_t)p.l * 48 + 36) * 1024 + q * 8) = (u32x4){0u, 0u, 0u, 0u}; return; }
    if (p.mode != 2) return;
    const int nblk = (p.N + 63) / 64, kb = p.r / nblk, nb = p.r - kb * nblk, k0 = 64 * kb, n0 = 64 * nb;
    const int l15 = lane & 15, l4 = lane >> 4;
    const bool ok = (n0 + 4 * l15) < p.N;
#pragma unroll
    for (int i = 0; i < 16; ++i) { LAS float* d = scr + (4 * i + l4) * 65 + 4 * l15; const f32x4 x = v[i]; d[0] = ok ? x[0] : 0.f; d[1] = ok ? x[1] : 0.f; d[2] = ok ? x[2] : 0.f; d[3] = ok ? x[3] : 0.f; }
    LDS_WAIT(); asm volatile("" ::: "memory");
    const int c = lane & 7; const MapAny map{p.kind, p.moff};
#pragma unroll
    for (int j = 0; j < 8; ++j) { const int n = (lane >> 3) + 8 * j; const LAS float* s_ = scr + (8 * c) * 65 + n;
        const int drow = map(n0 + n);
        if (p.f8 != 0.f && drow >= p.f8row) { const float fs = p.f8; u32x2 o; o.x = pk4_fp8(s_[0 * 65] * fs, s_[1 * 65] * fs, s_[2 * 65] * fs, s_[3 * 65] * fs); o.y = pk4_fp8(s_[4 * 65] * fs, s_[5 * 65] * fs, s_[6 * 65] * fs, s_[7 * 65] * fs);
            if (n0 + n < p.N) *(GAS u32x2*)(p.WT8b + (size_t)(drow - p.f8row) * p.ldk + p.koff + k0 + 8 * c) = o; }
        else { u32x4 o; o.x = pk2(s_[0 * 65], s_[1 * 65]); o.y = pk2(s_[2 * 65], s_[3 * 65]); o.z = pk2(s_[4 * 65], s_[5 * 65]); o.w = pk2(s_[6 * 65], s_[7 * 65]);
            if (n0 + n < p.N) *(GAS u32x4*)(p.WTb + (size_t)drow * p.ldk + p.koff + k0 + 8 * c) = o; } }
    LDS_WAIT(); asm volatile("" ::: "memory");
}
__device__ __forceinline__ void cv_direct(Frame& F, const CvP& p, int lane) {
    if (p.mode == 1) { const int q = p.r * 64 + lane; *(GAS u32x4*)(WSP(bf16, WS_WRT) + ((size_t)p.l * 48 + 36) * 1024 + q * 8) = (u32x4){0u, 0u, 0u, 0u}; return; }
    if (p.mode != 2) return;
    const int nblk = (p.N + 63) / 64, kb = p.r / nblk, nb = p.r - kb * nblk, k0 = 64 * kb, n = 64 * nb + lane;
    const bool ok = n < p.N;
    const GAS float* wp = p.W + (size_t)k0 * p.N + (ok ? n : 0);
    float x[64];
#pragma unroll
    for (int k = 0; k < 64; ++k) x[k] = wp[(size_t)k * p.N];
    const MapAny map{p.kind, p.moff}; const int drow = map(n);
    if (p.f8 != 0.f && drow >= p.f8row) { const float fs = p.f8; GAS unsigned char* op = p.WT8b + (size_t)(drow - p.f8row) * p.ldk + p.koff + k0;
#pragma unroll
        for (int q = 0; q < 4; ++q) { u32x4 o; o.x = pk4_fp8(x[16 * q] * fs, x[16 * q + 1] * fs, x[16 * q + 2] * fs, x[16 * q + 3] * fs); o.y = pk4_fp8(x[16 * q + 4] * fs, x[16 * q + 5] * fs, x[16 * q + 6] * fs, x[16 * q + 7] * fs);
            o.z = pk4_fp8(x[16 * q + 8] * fs, x[16 * q + 9] * fs, x[16 * q + 10] * fs, x[16 * q + 11] * fs); o.w = pk4_fp8(x[16 * q + 12] * fs, x[16 * q + 13] * fs, x[16 * q + 14] * fs, x[16 * q + 15] * fs);
            if (ok) *(GAS u32x4*)(op + 16 * q) = o; } }
    else { GAS bf16* op = p.WTb + (size_t)drow * p.ldk + p.koff + k0;
#pragma unroll
        for (int q = 0; q < 8; ++q) { u32x4 o; o.x = pk2(x[8 * q], x[8 * q + 1]); o.y = pk2(x[8 * q + 2], x[8 * q + 3]); o.z = pk2(x[8 * q + 4], x[8 * q + 5]); o.w = pk2(x[8 * q + 6], x[8 * q + 7]);
            if (ok) *(GAS u32x4*)(op + 8 * q) = o; } }
}
constexpr int CV_EXP0 = CV_IN + 2 * CV_BRA + CV_BRC + CV_OUT, CV_EXP1 = CV_EXP0 + NEXP * CV_EIN1 + NEXP * CV_EOUT1;
__device__ __forceinline__ void convert_layer(Frame& F, int l, int vb, int nvb) {
    LAS float* scr = (LAS float*)(F.lds + F.wave * (64 * 65 * 4));
    for (int ix = vb * NWAVES + F.wave; ix < CV_ITEMS - (CV_EXP1 - CV_EXP0); ix += nvb * NWAVES) convert_item(F, l, ix < CV_EXP0 ? ix : ix + (CV_EXP1 - CV_EXP0), scr);
}
__device__ __forceinline__ void build_tp(Frame& F, int l, LAS int* tp) {
    if (F.tid < 32) tp[33 + F.tid] = (int)__hip_atomic_load(WSP(unsigned, WS_CTL) + CW_CNT + l * 32 + F.tid, __ATOMIC_RELAXED, __HIP_MEMORY_SCOPE_AGENT);
    __syncthreads();
    if (F.tid == 0) { int s = 0; for (int e = 0; e < 32; ++e) { tp[e] = s; s += (tp[33 + e] + 255) >> 8; } tp[32] = s; }
    __syncthreads();
    { LAS unsigned char* em = (LAS unsigned char*)(tp + 72); const int TT = tp[32];
      for (int rt = F.tid; rt < TT; rt += NTHR) { int e = 0;
#pragma unroll
          for (int j = 1; j < 32; ++j) e = (tp[j] <= rt) ? j : e;
          em[rt] = (unsigned char)e; } }
    __syncthreads();
}

__device__ __forceinline__ void moe_combine_row(Frame& F, int row, const GAS bf16* x1row, const GAS float* gt2, const LAS int* tp, f32x4 (&v)[4]) {
    const GAS int* rt = WSP(int, WS_ROUTE) + (size_t)row * 8;
    const int e1 = rt[0], e2 = rt[1], p1 = rt[6], p2 = rt[7]; const float w1 = __int_as_float(rt[4]), w2 = __int_as_float(rt[5]);
    const GAS unsigned char* y1 = WSP(unsigned char, WS_YB) + ((size_t)tp[e1] * 256 + p1) * 1024, *y2 = WSP(unsigned char, WS_YB) + ((size_t)tp[e2] * 256 + p2) * 1024;
#pragma unroll
    for (int j = 0; j < 4; ++j) { const int col = 4 * F.lane + 256 * j;
        const u32x2 xw = *(const GAS u32x2*)(x1row + col); const f32x4 x = {bflo(xw.x), bfhi(xw.x), bflo(xw.y), bfhi(xw.y)}, g = *(const GAS f32x4*)(gt2 + col);
        const int a = *(const GAS int*)(y1 + col), b = *(const GAS int*)(y2 + col);
        const f32x2 a0 = __builtin_amdgcn_cvt_pk_f32_fp8(a, false), a1 = __builtin_amdgcn_cvt_pk_f32_fp8(a, true), b0 = __builtin_amdgcn_cvt_pk_f32_fp8(b, false), b1 = __builtin_amdgcn_cvt_pk_f32_fp8(b, true);
        f32x4 m; m[0] = w1 * a0[0] + w2 * b0[0]; m[1] = w1 * a0[1] + w2 * b0[1]; m[2] = w1 * a1[0] + w2 * b1[0]; m[3] = w1 * a1[1] + w2 * b1[1];
        v[j] = x + g * m; }
}
constexpr int NR1 = 1;
__device__ __forceinline__ void phase_norm1(Frame& F, int l) {
    LAS int* tp = (LAS int*)(F.lds);
    if (l > 0) build_tp(F, l - 1, tp);
    const int gw = F.bid * NWAVES + F.wave, NGW = F.G * NWAVES, rpw = NT / NGW;
    const GAS float* g1 = INP(4) + (size_t)l * 1024;
    for (int run = gw; run * rpw < NT; run += NGW) {
        const int r0 = run * rpw, b = r0 / SEQ;
        const GAS float* mb = WSP(float, WS_MOD) + ((size_t)l * 8 + b) * 6144;
        f32x4 gsc[4], shv[4], gt2[4];
#pragma unroll
        for (int j = 0; j < 4; ++j) { const int col = 4 * F.lane + 256 * j; const f32x4 g = *(const GAS f32x4*)(g1 + col), sc = *(const GAS f32x4*)(mb + 1024 + col);
            gsc[j] = g * (sc + 1.0f); shv[j] = *(const GAS f32x4*)(mb + col);
            gt2[j] = l > 0 ? *(const GAS f32x4*)(WSP(float, WS_MOD) + ((size_t)(l - 1) * 8 + b) * 6144 + 5 * 1024 + col) : zero4(); }
#pragma unroll 1
        for (int i = 0; i < rpw; i += NR1) {
            f32x4 v[NR1][4];
            if (l == 0) {
#pragma unroll
                for (int k = 0; k < NR1; ++k)
#pragma unroll
                    for (int j = 0; j < 4; ++j) v[k][j] = *(const GAS f32x4*)(INP(0) + (size_t)(r0 + i + k) * 1024 + 4 * F.lane + 256 * j);
            } else {
                int e1[NR1], e2[NR1], p1[NR1], p2[NR1]; float w1[NR1], w2[NR1];
#pragma unroll
                for (int k = 0; k < NR1; ++k) { const GAS int* rt = WSP(int, WS_ROUTE) + (size_t)(r0 + i + k) * 8; e1[k] = rt[0]; e2[k] = rt[1]; p1[k] = rt[6]; p2[k] = rt[7]; w1[k] = __int_as_float(rt[4]); w2[k] = __int_as_float(rt[5]); }
                u32x2 xw[NR1][4]; int ya[NR1][4], yb[NR1][4];
#pragma unroll
                for (int k = 0; k < NR1; ++k) { const GAS bf16* x1row = WSP(bf16, WS_X1) + (size_t)(r0 + i + k) * 1024;
                    const GAS unsigned char* y1 = WSP(unsigned char, WS_YB) + ((size_t)tp[e1[k]] * 256 + p1[k]) * 1024, *y2 = WSP(unsigned char, WS_YB) + ((size_t)tp[e2[k]] * 256 + p2[k]) * 1024;
#pragma unroll
                    for (int j = 0; j < 4; ++j) { const int col = 4 * F.lane + 256 * j; xw[k][j] = *(const GAS u32x2*)(x1row + col); ya[k][j] = *(const GAS int*)(y1 + col); yb[k][j] = *(const GAS int*)(y2 + col); } }
#pragma unroll
                for (int k = 0; k < NR1; ++k)
#pragma unroll
                    for (int j = 0; j < 4; ++j) { const int a = ya[k][j], bb = yb[k][j]; const u32x2 x_ = xw[k][j];
                        const f32x4 x = {bflo(x_.x), bfhi(x_.x), bflo(x_.y), bfhi(x_.y)};
                        const f32x2 a0 = __builtin_amdgcn_cvt_pk_f32_fp8(a, false), a1 = __builtin_amdgcn_cvt_pk_f32_fp8(a, true), b0 = __builtin_amdgcn_cvt_pk_f32_fp8(bb, false), b1 = __builtin_amdgcn_cvt_pk_f32_fp8(bb, true);
                        f32x4 m; m[0] = w1[k] * a0[0] + w2[k] * b0[0]; m[1] = w1[k] * a0[1] + w2[k] * b0[1]; m[2] = w1[k] * a1[0] + w2[k] * b1[0]; m[3] = w1[k] * a1[1] + w2[k] * b1[1];
                        v[k][j] = x + gt2[j] * m;
                        u32x2 xo; xo.x = pk2(v[k][j][0], v[k][j][1]); xo.y = pk2(v[k][j][2], v[k][j][3]); *(GAS u32x2*)(WSP(bf16, WS_XA) + (size_t)(r0 + i + k) * 1024 + 4 * F.lane + 256 * j) = xo; }
            }
#pragma unroll
            for (int k = 0; k < NR1; ++k) { float ss = 0.f;
#pragma unroll
                for (int j = 0; j < 4; ++j) ss += (v[k][j][0] * v[k][j][0] + v[k][j][1] * v[k][j][1]) + (v[k][j][2] * v[k][j][2] + v[k][j][3] * v[k][j][3]);
                const float rstd = rsqrtf(wave_sum(ss) * (1.f / 1024.f) + 1e-6f);
#pragma unroll
                for (int j = 0; j < 4; ++j) { const int col = 4 * F.lane + 256 * j; const f32x4 h = v[k][j] * rstd * gsc[j] + shv[j];
                    u32x2 o; o.x = pk2(h[0], h[1]); o.y = pk2(h[2], h[3]);
                    *(GAS u32x2*)(WSP(bf16, WS_H) + (size_t)(r0 + i + k) * 1024 + col) = o;
                    *(GAS unsigned*)(WSP(unsigned char, WS_H8) + (size_t)(r0 + i + k) * 1024 + col) = pk4_fp8(h[0], h[1], h[2], h[3]); } }
        }
    }
}
__device__ __forceinline__ void phase_final(Frame& F) {
    LAS int* tp = (LAS int*)(F.lds);
    build_tp(F, DEPTH - 1, tp);
    const int gw = F.bid * NWAVES + F.wave, NGW = F.G * NWAVES;
    for (int row = gw; row < NT; row += NGW) {
        const int b = row / SEQ; f32x4 v[4];
        moe_combine_row(F, row, WSP(bf16, WS_X1) + (size_t)row * 1024, WSP(float, WS_MOD) + ((size_t)(DEPTH - 1) * 8 + b) * 6144 + 5 * 1024, tp, v);
#pragma unroll
        for (int j = 0; j < 4; ++j) *(GAS f32x4*)(F.out + (size_t)row * 1024 + 4 * F.lane + 256 * j) = v[j];
    }
}

__device__ __forceinline__ float tanhf_(float x) { return 1.0f - 2.0f / (1.0f + __expf(2.0f * x)); }
__device__ __forceinline__ float logsigmoidf_(float x) { return x < 0.f ? x - log1pf(__expf(x)) : -log1pf(__expf(-x)); }
__device__ __forceinline__ void phase_prep(Frame& F, int l) {
    const GAS bf16* P = WSP(bf16, WS_P);
    GAS float* RW = WSP(float, WS_RW);
    {
        LAS unsigned char* L = F.lds;
        GAS float* RWSl = WSP(float, WS_RWS) + (size_t)l * NT * 1280;
        const GAS float* mu = INP(7) + (size_t)l * 1024; const GAS float* w0 = INP(8) + (size_t)l * 256; const GAS float* a0 = INP(10) + (size_t)l * 256;
        const GAS float* kkp = INP(13) + (size_t)l * 256; const GAS float* kap = INP(14) + (size_t)l * 256; const GAS float* rkp = INP(15) + (size_t)l * 256;
        const GAS bf16* w2t = WSP(bf16, WS_LORA) + (size_t)l * 65536; const GAS bf16* a2t = w2t + 256 * 64; const GAS bf16* g2t = w2t + 2 * 256 * 64;
        const int l15 = F.lane & 15, g = F.lane >> 4, h = F.wave >> 1, th = F.wave & 1;
        LAS float* PAR = (LAS float*)(F.lds + 34816);
        { const float ma = mu[F.tid]; float pv[6] = {0.f, 0.f, 0.f, 0.f, 0.f, 0.f};
          if (F.tid < 256) { pv[0] = mu[512 + F.tid]; pv[1] = w0[F.tid]; pv[2] = a0[F.tid]; pv[3] = kkp[F.tid]; pv[4] = kap[F.tid]; pv[5] = rkp[F.tid]; }
          PAR[F.tid] = ma;
          if (F.tid < 256) { PAR[512 + F.tid] = pv[0]; PAR[768 + F.tid] = pv[1]; PAR[1024 + F.tid] = pv[2]; PAR[1280 + F.tid] = pv[3]; PAR[1536 + F.tid] = pv[4]; PAR[1792 + F.tid] = pv[5]; } }
        for (int tt = F.bid; tt < NT / 64; tt += F.G) {
            const int t0 = tt * 64;
            { const int tok = F.tid >> 3, ch = F.tid & 7, c0 = 768 + 32 * ch, row = t0 + tok; const bool first = (row % SEQ) == 0;
              const GAS bf16* pr = P + (size_t)row * NINP + c0; const GAS bf16* pp = pr - (first ? 0 : NINP);
              u32x4 cw[4], pw[4]; f32x4 m4[8];
#pragma unroll
              for (int q = 0; q < 4; ++q) { cw[q] = *(const GAS u32x4*)(pr + 8 * q); pw[q] = *(const GAS u32x4*)(pp + 8 * q); }
#pragma unroll
              for (int j = 0; j < 8; ++j) m4[j] = *(const GAS f32x4*)(mu + c0 + 4 * j);
              const float ka = ch < 2 ? 2.0f : 1.0f;
#pragma unroll
              for (int q = 0; q < 4; ++q) { u32x4 o;
#pragma unroll
                  for (int e = 0; e < 4; ++e) {
                      const float c_lo = bflo(cw[q][e]), c_hi = bfhi(cw[q][e]), p_lo = first ? 0.f : bflo(pw[q][e]), p_hi = first ? 0.f : bfhi(pw[q][e]);
                      const float mu0 = m4[2 * q + (e >> 1)][2 * (e & 1)], mu1 = m4[2 * q + (e >> 1)][2 * (e & 1) + 1];
                      float m0 = c_lo + mu0 * (p_lo - c_lo), m1 = c_hi + mu1 * (p_hi - c_hi);
                      const float s0 = sigmoidf_(ka * m0), s1 = sigmoidf_(ka * m1);
                      m0 = ch < 2 ? 2.0f * s0 - 1.0f : (ch >= 4 ? s0 : m0); m1 = ch < 2 ? 2.0f * s1 - 1.0f : (ch >= 4 ? s1 : m1);
                      o[e] = pk2(m0, m1); }
                  *(LAS u32x4*)(L + tok * 528 + (32 * ch + 8 * q) * 2) = o; } }
            __syncthreads();
#pragma unroll 1
            for (int tb = 0; tb < 2; ++tb) {
                const int row = t0 + 32 * th + 16 * tb + l15; const bool first = (row % SEQ) == 0;
                const GAS bf16* pr = P + (size_t)row * NINP; const GAS bf16* pp = pr - (first ? 0 : NINP);
                f32x4 dw[4], da[4], dg[4];
#pragma unroll
                for (int cb = 0; cb < 4; ++cb) { dw[cb] = (f32x4){0.f, 0.f, 0.f, 0.f}; da[cb] = dw[cb]; dg[cb] = dw[cb]; }
                bf16x8 Uf[8];
#pragma unroll
                for (int ks = 0; ks < 8; ++ks) Uf[ks] = *(const LAS bf16x8*)(L + (32 * th + 16 * tb + l15) * 528 + (32 * ks + 8 * g) * 2);
                bf16x8 Aw[2][2], Aa[2][2], Ag[2][4];
#define LA_LOAD(buf, cbx) do { const int c_ = 64 * h + 16 * (cbx) + l15; \
                    _Pragma("unroll") for (int ks = 0; ks < 2; ++ks) { Aw[buf][ks] = *(const GAS bf16x8*)(w2t + c_ * 64 + 32 * ks + 8 * g); Aa[buf][ks] = *(const GAS bf16x8*)(a2t + c_ * 64 + 32 * ks + 8 * g); } \
                    _Pragma("unroll") for (int ks = 0; ks < 4; ++ks) Ag[buf][ks] = *(const GAS bf16x8*)(g2t + c_ * 128 + 32 * ks + 8 * g); } while (0)
#pragma unroll
                for (int cb = 0; cb < 4; ++cb) {
                    LA_LOAD(0, cb);
                    __builtin_amdgcn_sched_barrier(0);
#pragma unroll
                    for (int ks = 0; ks < 2; ++ks) { dw[cb] = PG8_MFMA(Aw[0][ks], Uf[ks], dw[cb]); da[cb] = PG8_MFMA(Aa[0][ks], Uf[2 + ks], da[cb]); }
#pragma unroll
                    for (int ks = 0; ks < 4; ++ks) dg[cb] = PG8_MFMA(Ag[0][ks], Uf[4 + ks], dg[cb]);
                    __builtin_amdgcn_sched_barrier(0); }
#undef LA_LOAD
                u32x2 cwv[4][3], pwv[4][3];
#pragma unroll
                for (int cb = 0; cb < 4; ++cb)
#pragma unroll
                    for (int q = 0; q < 3; ++q) { const int col = 64 * h + 16 * cb + 4 * g; cwv[cb][q] = *(const GAS u32x2*)(pr + 256 * q + col); pwv[cb][q] = *(const GAS u32x2*)(pp + 256 * q + col); }
                {
                f32x4 kkv[4], av_[4], vv[4], rr[4], k2[4], gsv[4]; float ss = 0.f, rks = 0.f;
#pragma unroll
                for (int cb = 0; cb < 4; ++cb) { const int col = 64 * h + 16 * cb + 4 * g;
                    f32x4 mx3[3];
#pragma unroll
                    for (int q = 0; q < 3; ++q) { const u32x2 cw = cwv[cb][q], pw = keep2(!first, pwv[cb][q]);
                        const f32x4 m4 = *(const LAS f32x4*)(PAR + 256 * q + col);
                        const f32x4 cv = {bflo(cw.x), bfhi(cw.x), bflo(cw.y), bfhi(cw.y)}, pv = {bflo(pw.x), bfhi(pw.x), bflo(pw.y), bfhi(pw.y)};
                        mx3[q] = cv + m4 * (pv - cv); }
                    const f32x4 w04 = *(const LAS f32x4*)(PAR + 768 + col), a04 = *(const LAS f32x4*)(PAR + 1024 + col), kk4 = *(const LAS f32x4*)(PAR + 1280 + col), ka4 = *(const LAS f32x4*)(PAR + 1536 + col), rk4 = *(const LAS f32x4*)(PAR + 1792 + col);
                    f32x4 dec, aa;
#pragma unroll
                    for (int i = 0; i < 4; ++i) { dec[i] = __expf(-0.60653066f * sigmoidf_(dw[cb][i] + w04[i])); aa[i] = sigmoidf_(da[cb][i] + a04[i]); }
                    rr[cb] = mx3[0]; vv[cb] = mx3[2]; av_[cb] = aa; kkv[cb] = mx3[1] * kk4; k2[cb] = mx3[1] * ((aa - 1.0f) * ka4 + 1.0f);
                    const f32x4 t1 = kkv[cb] * kkv[cb], t2 = rr[cb] * k2[cb] * rk4;
                    ss += (t1[0] + t1[1]) + (t1[2] + t1[3]); rks += (t2[0] + t2[1]) + (t2[2] + t2[3]);
                    const size_t o = (size_t)row * 256 + col, os = (size_t)row * 1280 + h * 320 + 16 * cb + 4 * g;
                    *(GAS f32x4*)(RWSl + os + RW_W * 64) = dec; *(GAS f32x4*)(RWSl + os + RW_K * 64) = k2[cb]; *(GAS f32x4*)(RWSl + os + RW_R * 64) = rr[cb];
                    *(GAS f32x4*)(RW + RW_V * RW_STRIDE + o) = vv[cb]; gsv[cb] = dg[cb]; }
                ss += shx(ss, F.lane, 16); ss += shx(ss, F.lane, 32); rks += shx(rks, F.lane, 16); rks += shx(rks, F.lane, 32);
                const float kinv = 1.0f / fmaxf(sqrtf(ss), 1e-12f);
#pragma unroll
                for (int cb = 0; cb < 4; ++cb) { const size_t o = (size_t)row * 256 + 64 * h + 16 * cb + 4 * g, os = (size_t)row * 1280 + h * 320 + 16 * cb + 4 * g; const f32x4 kkn = kkv[cb] * kinv;
                    *(GAS f32x4*)(RWSl + os + RW_AV * 64) = -kkn; *(GAS f32x4*)(RWSl + os + RW_BV * 64) = kkn * av_[cb]; const f32x4 bo = vv[cb] * rks, gg = gsv[cb];
                    u32x4 pw; pw.x = pk2(bo[0], gg[0]); pw.y = pk2(bo[1], gg[1]); pw.z = pk2(bo[2], gg[2]); pw.w = pk2(bo[3], gg[3]);
                    *(GAS u32x4*)((GAS unsigned*)(RW + RW_G * RW_STRIDE) + o) = pw; } } }
            __syncthreads();
        }
    }
    {
        const GAS float* cw = INP(18) + (size_t)l * 4 * 512; const GAS float* cb = INP(19) + (size_t)l * 512;
        const GAS float* bi = INP(20) + (size_t)l * 4; const GAS float* bfp = INP(21) + (size_t)l * 4;
        GAS bf16* QKB = WSP(bf16, WS_QKB); GAS float* GT = WSP(float, WS_GATES);
        const int c8 = (F.tid & 63) * 8;
        f32x4 wv[4][2]; f32x4 cbv[2];
#pragma unroll
        for (int j = 0; j < 4; ++j) { wv[j][0] = *(const GAS f32x4*)(cw + j * 512 + c8); wv[j][1] = *(const GAS f32x4*)(cw + j * 512 + c8 + 4); }
        cbv[0] = *(const GAS f32x4*)(cb + c8); cbv[1] = *(const GAS f32x4*)(cb + c8 + 4);
        const float sc = c8 >= 256 ? 0.125f : 1.0f;
        const f32x4 bi4 = *(const GAS f32x4*)bi, bf4 = *(const GAS f32x4*)bfp;
        for (int run = F.bid * 8 + (F.tid >> 6); run < NT / 8; run += F.G * 8) {
            const int rbase = run * 8, tb0 = rbase % SEQ;
            u32x4 xr[11], gv[8];
#pragma unroll
            for (int i = 0; i < 11; ++i) xr[i] = *(const GAS u32x4*)(P + (size_t)((i < 3 && tb0 == 0) ? rbase : rbase - 3 + i) * NINP + PC_QB + c8);
#pragma unroll
            for (int rr = 0; rr < 8; ++rr) gv[rr] = *(const GAS u32x4*)(P + (size_t)(rbase + rr) * NINP + PC_IB);
            if (tb0 == 0) { xr[0] = (u32x4){0u, 0u, 0u, 0u}; xr[1] = xr[0]; xr[2] = xr[0]; }
#pragma unroll
            for (int rr = 0; rr < 8; ++rr) { const int row = rbase + rr;
                f32x4 a0 = cbv[0], a1 = cbv[1];
#pragma unroll
                for (int j = 0; j < 4; ++j) { const u32x4 xv = xr[rr + j];
                    const f32x4 x0 = {bflo(xv.x), bfhi(xv.x), bflo(xv.y), bfhi(xv.y)}, x1 = {bflo(xv.z), bfhi(xv.z), bflo(xv.w), bfhi(xv.w)};
                    a0 = wv[j][0] * x0 + a0; a1 = wv[j][1] * x1 + a1; }
                float acc[8] = {a0[0], a0[1], a0[2], a0[3], a1[0], a1[1], a1[2], a1[3]};
#pragma unroll
                for (int e = 0; e < 8; ++e) acc[e] = acc[e] * sigmoidf_(acc[e]) * sc;
                u32x4 o; o.x = pk2(acc[0], acc[1]); o.y = pk2(acc[2], acc[3]); o.z = pk2(acc[4], acc[5]); o.w = pk2(acc[6], acc[7]);
                *(GAS u32x4*)(QKB + (size_t)row * 512 + c8) = o;
                if ((F.tid & 63) == 0) { const u32x4 g4 = gv[rr];
                    f32x4 ig, lf;
                    ig[0] = bflo(g4.x) + bi4[0]; ig[1] = bfhi(g4.x) + bi4[1]; ig[2] = bflo(g4.y) + bi4[2]; ig[3] = bfhi(g4.y) + bi4[3];
                    lf[0] = logsigmoidf_(bflo(g4.z) + bf4[0]); lf[1] = logsigmoidf_(bfhi(g4.z) + bf4[1]); lf[2] = logsigmoidf_(bflo(g4.w) + bf4[2]); lf[3] = logsigmoidf_(bfhi(g4.w) + bf4[3]);
                    *(GAS f32x4*)(GT + (size_t)row * 8) = ig; *(GAS f32x4*)(GT + (size_t)row * 8 + 4) = lf; }
            }
        }
    }
}

#define CAS __attribute__((address_space(4)))
typedef float f32x16 __attribute__((ext_vector_type(16)));
__device__ __forceinline__ int fragpos(int j) { return ((j >> 4) * 2 + ((j >> 2) & 1)) * 8 + ((j >> 3) & 1) * 4 + (j & 3); }
constexpr int SC_CH = 64, SC_NCH = SEQ / SC_CH;
__device__ __forceinline__ void scan_local_block(Frame& F, int l, int grp) {
    const int k = F.wave & 3, lane = F.lane;
    const int b = grp / SC_NCH, c = grp % SC_NCH, h = k, bh = 4 * b + h;
    const size_t tok0 = (size_t)b * SEQ + c * SC_CH;
    LAS unsigned char* ring = F.lds + k * 20480;
    const GAS float* src = WSP(float, WS_RWS) + ((size_t)l * NT + tok0) * 1280 + h * 320;
    if (F.wave >= 4) {
        f32x4 ld[10];
        const int e0s = lane >> 4, e0q = lane & 15;
#define S1_FETCH(sub) do { const GAS float* sb_ = src + (size_t)(8 * (sub)) * 1280; \
            _Pragma("unroll") for (int i = 0; i < 8; ++i) ld[i] = *(const GAS f32x4*)(sb_ + i * 1280 + 4 * lane); \
            ld[8] = *(const GAS f32x4*)(sb_ + e0s * 1280 + 256 + 4 * e0q); ld[9] = *(const GAS f32x4*)(sb_ + (e0s + 4) * 1280 + 256 + 4 * e0q); } while (0)
#define S1_PUT(buf) do { LAS unsigned char* rb_ = ring + (buf) * 10240; \
            _Pragma("unroll") for (int i = 0; i < 8; ++i) *(LAS f32x4*)(rb_ + i * 1280 + lane * 16) = ld[i]; \
            *(LAS f32x4*)(rb_ + e0s * 1280 + 1024 + e0q * 16) = ld[8]; *(LAS f32x4*)(rb_ + (e0s + 4) * 1280 + 1024 + e0q * 16) = ld[9]; } while (0)
        S1_FETCH(0); S1_PUT(0);
        __syncthreads();
        LAS float* cscr = (LAS float*)(F.lds + 81920 + (F.wave - 4) * 16640);
        int cit = grp * 4 + (F.wave - 4);
#pragma unroll 1
        for (int sub = 0; sub < SC_CH / 8; ++sub) {
            if (sub + 1 < SC_CH / 8) S1_FETCH(sub + 1);
#pragma unroll 1
            for (int j = 0; j < 2; ++j) {
                const bool ex = cit >= CV_EXP0 && cit < CV_EXP1;
                int lnc = lane; asm volatile("" : "+v"(lnc));
                const CvP p_ = convert_params(F, ex ? l : l + 1, cit, cit < CV_ITEMS && (ex || l + 1 < DEPTH));
                cv_direct(F, p_, lnc);
                cit += 1024; }
            if (sub + 1 < SC_CH / 8) S1_PUT((sub + 1) & 1);
            __syncthreads();
        }
#undef S1_FETCH
#undef S1_PUT
        return;
    }
    f32x2 Xs[32], Ls[32];
    int ln = lane; asm volatile("" : "+v"(ln));
#pragma unroll
    for (int p = 0; p < 32; ++p) { Xs[p][0] = (ln == 2 * p) ? 1.f : 0.f; Xs[p][1] = (ln == 2 * p + 1) ? 1.f : 0.f; Ls[p] = (f32x2){0.f, 0.f}; }
    const GAS float* vp = WSP(float, WS_RW) + RW_V * RW_STRIDE + tok0 * 256 + 64 * h + lane;
    GAS bf16* YL = WSP(bf16, WS_YL) + (size_t)(bh * SC_NCH + c) * 4096 + (ln >> 5) * 1024 + (ln & 31) * 8;
    GAS bf16* ZB = WSP(bf16, WS_ZB) + (size_t)(bh * SC_NCH + c) * 4096 + (fragpos(ln) >> 3) * 256 + (fragpos(ln) & 7);
    float vcur = vp[0];
    __syncthreads();
#pragma unroll 1
    for (int sub = 0; sub < SC_CH / 8; ++sub) {
        const LAS unsigned char* sbuf = ring + (sub & 1) * 10240;
#pragma unroll 1
        for (int st = 0; st < 8; ++st) {
            const LAS unsigned char* q = sbuf + st * 1280;
            const int t = 8 * sub + st;
            const float vnext = (t + 1 < SC_CH) ? vp[(size_t)(t + 1) * 256] : 0.f;
#define S1_SB __builtin_amdgcn_sched_barrier(0)
            f32x2 d0 = {0.f, 0.f}, d1 = {0.f, 0.f}, e0 = {0.f, 0.f}, e1 = {0.f, 0.f};
            f32x4 aq[3][2];
#pragma unroll
            for (int g = 0; g < 2; ++g)
#pragma unroll
                for (int i = 0; i < 2; ++i) aq[g][i] = *(const LAS f32x4*)(q + RW_AV * 256 + 16 * (2 * g + i));
            f32x4 wq[3], bq[3], rq[3], kq[3];
#pragma unroll
            for (int j = 0; j < 2; ++j) { wq[j] = *(const LAS f32x4*)(q + RW_W * 256 + 16 * j); bq[j] = *(const LAS f32x4*)(q + RW_BV * 256 + 16 * j); rq[j] = *(const LAS f32x4*)(q + RW_R * 256 + 16 * j); kq[j] = *(const LAS f32x4*)(q + RW_K * 256 + 16 * j); }
#pragma unroll
            for (int g4 = 0; g4 < 8; ++g4) {
                if (g4 + 2 < 8) {
#pragma unroll
                    for (int i = 0; i < 2; ++i) aq[(g4 + 2) % 3][i] = *(const LAS f32x4*)(q + RW_AV * 256 + 16 * (2 * (g4 + 2) + i)); }
                S1_SB;
#pragma unroll
                for (int i = 0; i < 2; ++i) { const int jq = 2 * g4 + i; const f32x4 a4 = aq[g4 % 3][i]; const f32x2 aL = {a4[0], a4[1]}, aH = {a4[2], a4[3]};
                    d0 = Xs[2 * jq] * aL + d0; d1 = Xs[2 * jq + 1] * aH + d1; e0 = Ls[2 * jq] * aL + e0; e1 = Ls[2 * jq + 1] * aH + e1; }
                S1_SB;
            }
            const float sax = (d0[0] + d0[1]) + (d1[0] + d1[1]), sal = (e0[0] + e0[1]) + (e1[0] + e1[1]);
            const f32x2 sx2 = {sax, sax}, sl2 = {sal, sal}, v2 = {vcur, vcur};
            f32x2 z0 = {0.f, 0.f}, z1 = {0.f, 0.f}, y0 = {0.f, 0.f}, y1 = {0.f, 0.f};
#pragma unroll
            for (int jq = 0; jq < 16; ++jq) {
                if (jq + 2 < 16) { const int jn = jq + 2; wq[jn % 3] = *(const LAS f32x4*)(q + RW_W * 256 + 16 * jn); bq[jn % 3] = *(const LAS f32x4*)(q + RW_BV * 256 + 16 * jn);
                    rq[jn % 3] = *(const LAS f32x4*)(q + RW_R * 256 + 16 * jn); kq[jn % 3] = *(const LAS f32x4*)(q + RW_K * 256 + 16 * jn); }
                S1_SB;
                { const f32x4 w4 = wq[jq % 3], b4 = bq[jq % 3], r4 = rq[jq % 3], k4 = kq[jq % 3];
                    const f32x2 wL = {w4[0], w4[1]}, wH = {w4[2], w4[3]}, bL = {b4[0], b4[1]}, bH = {b4[2], b4[3]}, rL = {r4[0], r4[1]}, rH = {r4[2], r4[3]}, kL = {k4[0], k4[1]}, kH = {k4[2], k4[3]};
                    const f32x2 xa = Xs[2 * jq] * wL + sx2 * bL, xb = Xs[2 * jq + 1] * wH + sx2 * bH;
                    const f32x2 la = v2 * kL + (Ls[2 * jq] * wL + sl2 * bL), lb = v2 * kH + (Ls[2 * jq + 1] * wH + sl2 * bH);
                    Xs[2 * jq] = xa; Xs[2 * jq + 1] = xb; Ls[2 * jq] = la; Ls[2 * jq + 1] = lb;
                    z0 = xa * rL + z0; z1 = xb * rH + z1; y0 = la * rL + y0; y1 = lb * rH + y1; }
                S1_SB;
            }
#undef S1_SB
            const float z = (z0[0] + z0[1]) + (z1[0] + z1[1]), y = (y0[0] + y0[1]) + (y1[0] + y1[1]);
            YL[(t >> 5) * 2048 + ((t >> 4) & 1) * 512 + ((t >> 2) & 1) * 256 + ((t >> 3) & 1) * 4 + (t & 3)] = (bf16)(pk2(y, 0.f) & 0xffffu); ZB[(t >> 5) * 2048 + (t & 31) * 8] = (bf16)(pk2(z, 0.f) & 0xffffu);
            vcur = vnext;
        }
        __syncthreads();
    }
    {
        const size_t ob = ((size_t)(bh * SC_NCH + c) * 64) * 64;
        int ln2 = lane; asm volatile("" : "+v"(ln2));
        GAS bf16* UT = WSP(bf16, WS_UT) + ob + (ln2 >> 5) * 2048 + (ln2 & 31) * 8; GAS bf16* PT = WSP(bf16, WS_PT) + ob + (fragpos(ln2) >> 3) * 256 + (fragpos(ln2) & 7);
#pragma unroll
        for (int g8 = 0; g8 < 8; ++g8) {
            const int rb = g8 >> 2, hf = (g8 >> 1) & 1, hq = g8 & 1, m0 = 8 * rb + 4 * hf + hq;
            u32x4 w; w.x = pk2(Ls[2 * m0][0], Ls[2 * m0][1]); w.y = pk2(Ls[2 * m0 + 1][0], Ls[2 * m0 + 1][1]); w.z = pk2(Ls[2 * m0 + 4][0], Ls[2 * m0 + 4][1]); w.w = pk2(Ls[2 * m0 + 5][0], Ls[2 * m0 + 5][1]);
            *(GAS u32x4*)(UT + rb * 1024 + hf * 512 + hq * 256) = w; }
#pragma unroll
        for (int p = 0; p < 32; ++p) { const unsigned w = pk2(Xs[p][0], Xs[p][1]);
            PT[((2 * p) >> 5) * 2048 + ((2 * p) & 31) * 8] = (bf16)(w & 0xffffu); PT[((2 * p + 1) >> 5) * 2048 + ((2 * p + 1) & 31) * 8] = (bf16)(w >> 16); }
    }
}
constexpr int S2_RING = 4, S2_SPIN = 1 << 22;
__device__ __forceinline__ void s2_wait_ge(volatile LAS int* p, int need) { int it = 0; while (*p < need) { __builtin_amdgcn_s_sleep(1); if (++it > S2_SPIN) break; } asm volatile("" ::: "memory"); }
__device__ __forceinline__ void s2_publish(volatile LAS int* p, int v, int lane) { asm volatile("s_waitcnt lgkmcnt(0)" ::: "memory"); if (lane == 0) *p = v; asm volatile("" ::: "memory"); }
__device__ __forceinline__ void scan_combine_unit(Frame& F, int l, int bh) {
    const int b = bh >> 2, h = bh & 3, w = F.wave, lane = F.lane, r = lane & 31, hh = lane >> 5;
    LAS unsigned char* FR = F.lds;
    volatile LAS int* PRG = (volatile LAS int*)(F.lds + 32768);
    LAS float* ST = (LAS float*)(F.lds + 33024);
    if (F.tid < 16) PRG[F.tid] = 0;
    __syncthreads();
#define RQU(q) (((q) & 3) + 8 * ((q) >> 2))
    if (w < 2) {
        const int cb = w;
        const GAS bf16* UTg = WSP(bf16, WS_UT); const GAS bf16* PTg = WSP(bf16, WS_PT);
        int lz = lane; asm volatile("" : "+v"(lz));
        const unsigned lo_pt = lz * 8, lo_ut = cb * 2048 + lz * 8;
        f32x16 X0, X1;
#pragma unroll
        for (int q = 0; q < 16; ++q) { X0[q] = 0.f; X1[q] = 0.f; }
        f32x16 aU0, aU1, bU0, bU1; bf16x8 aP[2][4], bP[2][4];
#define S2_LOAD_S(U0_, U1_, P_, c_) do { const size_t pb = (size_t)(bh * SC_NCH + (c_)) * 4096; \
        _Pragma("unroll") for (int hf = 0; hf < 2; ++hf) { const u32x4 t0 = *(const GAS u32x4*)((UTg + pb + hf * 512) + lo_ut), t1 = *(const GAS u32x4*)((UTg + pb + 1024 + hf * 512) + lo_ut); \
            U0_[8 * hf] = bflo(t0.x); U0_[8 * hf + 1] = bfhi(t0.x); U0_[8 * hf + 2] = bflo(t0.y); U0_[8 * hf + 3] = bfhi(t0.y); U0_[8 * hf + 4] = bflo(t0.z); U0_[8 * hf + 5] = bfhi(t0.z); U0_[8 * hf + 6] = bflo(t0.w); U0_[8 * hf + 7] = bfhi(t0.w); \
            U1_[8 * hf] = bflo(t1.x); U1_[8 * hf + 1] = bfhi(t1.x); U1_[8 * hf + 2] = bflo(t1.y); U1_[8 * hf + 3] = bfhi(t1.y); U1_[8 * hf + 4] = bflo(t1.z); U1_[8 * hf + 5] = bfhi(t1.z); U1_[8 * hf + 6] = bflo(t1.w); U1_[8 * hf + 7] = bfhi(t1.w); } \
        _Pragma("unroll") for (int s4 = 0; s4 < 4; ++s4) { P_[0][s4] = *(const GAS bf16x8*)((PTg + pb + s4 * 512) + lo_pt); P_[1][s4] = *(const GAS bf16x8*)((PTg + pb + 2048 + s4 * 512) + lo_pt); } } while (0)
#define S2_TRIP_S(c, U0_, U1_, P_) do { \
        u32x4 fg[4]; \
        _Pragma("unroll") for (int s2 = 0; s2 < 2; ++s2) { fg[s2].x = pk2(X0[8 * s2 + 0], X0[8 * s2 + 1]); fg[s2].y = pk2(X0[8 * s2 + 2], X0[8 * s2 + 3]); fg[s2].z = pk2(X0[8 * s2 + 4], X0[8 * s2 + 5]); fg[s2].w = pk2(X0[8 * s2 + 6], X0[8 * s2 + 7]); \
            fg[2 + s2].x = pk2(X1[8 * s2 + 0], X1[8 * s2 + 1]); fg[2 + s2].y = pk2(X1[8 * s2 + 2], X1[8 * s2 + 3]); fg[2 + s2].z = pk2(X1[8 * s2 + 4], X1[8 * s2 + 5]); fg[2 + s2].w = pk2(X1[8 * s2 + 6], X1[8 * s2 + 7]); } \
        if ((c) >= S2_RING) { const int m0 = 2 * ((c) - S2_RING); s2_wait_ge(PRG + 2 + 2 * (m0 % 3) + cb, m0 + 1); s2_wait_ge(PRG + 2 + 2 * ((m0 + 1) % 3) + cb, m0 + 2); }        \
        { LAS unsigned char* sl = FR + (cb * S2_RING + ((c) & (S2_RING - 1))) * 4096 + lane * 16; \
          _Pragma("unroll") for (int s4 = 0; s4 < 4; ++s4) *(LAS u32x4*)(sl + s4 * 1024) = fg[s4]; } \
        s2_publish(PRG + cb, (c) + 1, lane); \
        X0 = U0_; X1 = U1_; \
        _Pragma("unroll") for (int s4 = 0; s4 < 4; ++s4) { const bf16x8 Bf = __builtin_bit_cast(bf16x8, fg[s4]); \
            X0 = __builtin_amdgcn_mfma_f32_32x32x16_bf16(P_[0][s4], Bf, X0, 0, 0, 0); X1 = __builtin_amdgcn_mfma_f32_32x32x16_bf16(P_[1][s4], Bf, X1, 0, 0, 0); } \
        S2_LOAD_S(U0_, U1_, P_, ((c) + 2 < SC_NCH ? (c) + 2 : SC_NCH - 1)); } while (0)
        S2_LOAD_S(aU0, aU1, aP, 0); S2_LOAD_S(bU0, bU1, bP, 1);
#pragma unroll 1
        for (int c2 = 0; c2 < SC_NCH; c2 += 2) { S2_TRIP_S(c2, aU0, aU1, aP); S2_TRIP_S(c2 + 1, bU0, bU1, bP); }
#undef S2_TRIP_S
#undef S2_LOAD_S
    } else {
        const int ow = w - 2, pair = ow >> 1, cb = ow & 1;
        LAS float* TT = (LAS float*)(F.lds + 57600) + ow * 1152;
        LAS bf16* OT = (LAS bf16*)(F.lds + 85248) + ow * 1280;
        LAS float* MR = (LAS float*)(F.lds + 100608) + ow * 64;
        const GAS bf16* ZBg = WSP(bf16, WS_ZB); const GAS bf16* YLg = WSP(bf16, WS_YL);
        const GAS unsigned* BG = (const GAS unsigned*)(WSP(float, WS_RW) + RW_G * RW_STRIDE); GAS bf16* YC = WSP(bf16, WS_YCAT);
        GAS bf16* DUMY = (GAS bf16*)(WSP(float, WS_RW) + RW_Y * RW_STRIDE) + (size_t)(bh * 6 + ow) * 32768;
        const int icol = 64 * h + 32 * cb + r;
        const float lgv = INP(16)[(size_t)l * 256 + icol], lbv = INP(17)[(size_t)l * 256 + icol];
        int lz = lane; asm volatile("" : "+v"(lz));
        const unsigned lo_z = lz * 8, lo_tok = 4 * (lz >> 5) * 256 + 64 * h + 32 * cb + (lz & 31), lo_yl = cb * 1024 + lz * 8, lo_yp = (lz & 31) * 1024 + 64 * h + 32 * cb + 16 * (lz >> 5);
        unsigned bv[16];
#pragma unroll
        for (int q = 0; q < 16; ++q) bv[q] = 0u;
        f32x16 aI, bI; bf16x8 aA[4], bA[4];
        constexpr int NTRIP = 22;
#define S2_LOAD_O(I_, A_, m_) do { const int mm = (m_) < 64 ? (m_) : 63; const size_t pb = (size_t)(bh * SC_NCH + (mm >> 1)) * 4096 + (mm & 1) * 2048; \
        _Pragma("unroll") for (int hf = 0; hf < 2; ++hf) { const u32x4 t4 = *(const GAS u32x4*)((YLg + pb + hf * 512) + lo_yl); \
            I_[8 * hf] = bflo(t4.x); I_[8 * hf + 1] = bfhi(t4.x); I_[8 * hf + 2] = bflo(t4.y); I_[8 * hf + 3] = bfhi(t4.y); I_[8 * hf + 4] = bflo(t4.z); I_[8 * hf + 5] = bfhi(t4.z); I_[8 * hf + 6] = bflo(t4.w); I_[8 * hf + 7] = bfhi(t4.w); } \
        _Pragma("unroll") for (int s4 = 0; s4 < 4; ++s4) A_[s4] = *(const GAS bf16x8*)((ZBg + pb + s4 * 512) + lo_z); } while (0)
#define S2_FINAL(mp, ip, real) do { const LAS float* sp_ = ST + ((ip) & 7) * 768 + pair * 256 + r * 2; const size_t tk = (size_t)b * SEQ + (mp) * 32; \
        { const f32x2 s0_ = *(const LAS f32x2*)(sp_), s1_ = *(const LAS f32x2*)(sp_ + 64), s2_ = *(const LAS f32x2*)(sp_ + 128), s3_ = *(const LAS f32x2*)(sp_ + 192); \
          const float mu = ((s0_[0] + s1_[0]) + (s2_[0] + s3_[0])) * (1.f / 64.f), var = ((s0_[1] + s1_[1]) + (s2_[1] + s3_[1])) * (1.f / 64.f) - mu * mu; \
          *(LAS f32x2*)(MR + r * 2) = (f32x2){mu, rsqrtf(fmaxf(var, 0.f) + 64e-5f)}; }        \
        asm volatile("s_waitcnt lgkmcnt(0)" ::: "memory"); \
        _Pragma("unroll") for (int q = 0; q < 16; ++q) { const int rq = RQU(q) + 4 * hh; const f32x2 mr_ = *(const LAS f32x2*)(MR + rq * 2); \
            const float yn = ((TT[rq * 36 + r] - mr_[0]) * mr_[1]) * lgv + lbv; \
            OT[rq * 40 + r] = (bf16)(pk2((yn + bflo(bv[q])) * bfhi(bv[q]), 0.f) & 0xffffu); } \
        asm volatile("s_waitcnt lgkmcnt(0)" ::: "memory"); \
        { const u32x4 o0 = *(const LAS u32x4*)(OT + r * 40 + 16 * hh), o1 = *(const LAS u32x4*)(OT + r * 40 + 16 * hh + 8); GAS bf16* yp = ((real) ? YC + tk * 1024 : DUMY) + lo_yp; \
          *(GAS u32x4*)yp = o0; *(GAS u32x4*)(yp + 8) = o1; } } while (0)
#define S2_TRIP_O(i, I_, A_) do { const int mr0 = pair + 3 * (i), m = mr0 < 64 ? mr0 : 63, c = m >> 1; \
        s2_wait_ge(PRG + cb, c + 1); \
        { const LAS unsigned char* sl = FR + (cb * S2_RING + (c & (S2_RING - 1))) * 4096 + lane * 16; \
          bf16x8 Bf[4]; _Pragma("unroll") for (int s4 = 0; s4 < 4; ++s4) Bf[s4] = *(const LAS bf16x8*)(sl + s4 * 1024); \
          _Pragma("unroll") for (int s4 = 0; s4 < 4; ++s4) I_ = __builtin_amdgcn_mfma_f32_32x32x16_bf16(A_[s4], Bf[s4], I_, 0, 0, 0); } \
        s2_publish(PRG + 2 + ow, m + 1, lane); \
        s2_wait_ge(PRG + 8 + (ow ^ 1), (i)); S2_FINAL(mr0 - 3, (i) - 1, (i) > 0); \
        { const size_t tk = (size_t)b * SEQ + m * 32; \
          _Pragma("unroll") for (int q = 0; q < 16; ++q) bv[q] = (BG + (tk + RQU(q)) * 256)[lo_tok]; } \
        _Pragma("unroll") for (int q = 0; q < 16; ++q) TT[(RQU(q) + 4 * hh) * 36 + r] = I_[q]; \
        S2_LOAD_O(I_, A_, mr0 + 6); \
        asm volatile("s_waitcnt lgkmcnt(0)" ::: "memory"); \
        { float s1 = 0.f, s2 = 0.f;        \
            _Pragma("unroll") for (int j = 0; j < 4; ++j) { const f32x4 t4 = *(const LAS f32x4*)(TT + r * 36 + 16 * hh + 4 * j); s1 += (t4[0] + t4[1]) + (t4[2] + t4[3]); s2 += (t4[0] * t4[0] + t4[1] * t4[1]) + (t4[2] * t4[2] + t4[3] * t4[3]); } \
            *(LAS f32x2*)(ST + ((i) & 7) * 768 + pair * 256 + cb * 128 + hh * 64 + r * 2) = (f32x2){s1, s2}; } \
        s2_publish(PRG + 8 + ow, (i) + 1, lane); } while (0)
        S2_LOAD_O(aI, aA, pair); S2_LOAD_O(bI, bA, pair + 3);
#pragma unroll 1
        for (int i2 = 0; i2 < NTRIP; i2 += 2) { S2_TRIP_O(i2, aI, aA); S2_TRIP_O(i2 + 1, bI, bA); }
        s2_wait_ge(PRG + 8 + (ow ^ 1), NTRIP); S2_FINAL(pair + 3 * (NTRIP - 1), NTRIP - 1, pair == 0);
#undef S2_TRIP_O
#undef S2_FINAL
#undef S2_LOAD_O
    }
#undef RQU
    __syncthreads();
}
constexpr int ML_QS = 0, ML_KS = 18432, ML_VT = 36864, ML_WKT = 54272, ML_CB = 88064, ML_NF = 97280, ML_FC = 97536, ML_IG = 98048, ML_GW = 98560, ML_PM = 99072, ML_TMP = 100352;
constexpr int MS_STRIDE = 4224;
__device__ __forceinline__ void mlstm_summary_unit(Frame& F, int l, int u) {
    const int bh = u >> 4, c = u & 15, b = bh >> 2, h = bh & 3;
    LAS unsigned char* L = F.lds;
    LAS float* Fc = (LAS float*)(L + ML_FC); LAS float* ig = (LAS float*)(L + ML_IG); LAS float* gw = (LAS float*)(L + ML_GW); LAS float* pm = (LAS float*)(L + ML_PM); LAS float* tmp = (LAS float*)(L + ML_TMP);
    const GAS bf16* P = WSP(bf16, WS_P); const GAS bf16* QKB = WSP(bf16, WS_QKB); const GAS float* GT = WSP(float, WS_GATES);
    GAS float* MS = WSP(float, WS_MSUM) + (size_t)u * MS_STRIDE;
    const int lane = F.lane, l15 = lane & 15, g = lane >> 4, w = F.wave;
    const size_t row0 = (size_t)b * SEQ + c * 128;
    u32x4 kxq[2][4], vvq[2];
    const int c8m = (F.tid & 7) * 8;
#pragma unroll
    for (int j = 0; j < 2; ++j) { const int r = (F.tid + NTHR * j) >> 3;
#pragma unroll
        for (int t = 0; t < 4; ++t) { const int pos = c * 128 + r - 3 + t; kxq[j][t] = *(const GAS u32x4*)(P + ((size_t)b * SEQ + (pos >= 0 ? pos : 0)) * NINP + PC_KB + 64 * h + c8m); }
        vvq[j] = *(const GAS u32x4*)(P + (row0 + r) * NINP + PC_VB + 64 * h + c8m); }
    f32x4 wvm[4][2], cbm[2];
    { const GAS float* cwp = INP(18) + (size_t)l * 4 * 512 + 256 + 64 * h + c8m; const GAS float* cbp = INP(19) + (size_t)l * 512 + 256 + 64 * h + c8m;
#pragma unroll
      for (int t = 0; t < 4; ++t) { wvm[t][0] = *(const GAS f32x4*)(cwp + t * 512); wvm[t][1] = *(const GAS f32x4*)(cwp + t * 512 + 4); }
      cbm[0] = *(const GAS f32x4*)cbp; cbm[1] = *(const GAS f32x4*)(cbp + 4); }
    const float bim = INP(20)[(size_t)l * 4 + h], bfm = INP(21)[(size_t)l * 4 + h];
    {
        float igv = 0.f, Fv = 0.f, pmv = -3.0e38f;
        if (F.tid < 128) { { const GAS unsigned short* pg = (const GAS unsigned short*)(P + (row0 + F.tid) * NINP + PC_IB + h); igv = bflo((unsigned)pg[0]) + bim; Fv = logsigmoidf_(bflo((unsigned)pg[4]) + bfm); }
#pragma unroll
            for (int o = 1; o < 64; o <<= 1) { const float n = shup(Fv, F.lane, o); if (lane >= o) Fv += n; }
            if (F.tid == 63) tmp[0] = Fv; }
        __syncthreads();
        if (F.tid < 128) { if (F.tid >= 64) Fv += tmp[0];
            pmv = igv - Fv;
#pragma unroll
            for (int o = 1; o < 64; o <<= 1) { const float n = shup(pmv, F.lane, o); if (lane >= o) pmv = fmaxf(pmv, n); }
            if (F.tid == 63) tmp[1] = pmv;
            ig[F.tid] = igv; Fc[F.tid] = Fv; }
        __syncthreads();
        if (F.tid >= 64 && F.tid < 128) pmv = fmaxf(pmv, tmp[1]);
        if (F.tid < 128) pm[F.tid] = pmv;
        __syncthreads();
        const float fl = Fc[127], m_loc = fl + pm[127];
        if (F.tid < 128) gw[F.tid] = __expf(fl - Fv + igv - m_loc);
        __syncthreads();
#pragma unroll
        for (int j = 0; j < 2; ++j) { const int it = F.tid + NTHR * j, r = it >> 3, c8 = (it & 7) * 8;
            f32x4 a0 = cbm[0], a1 = cbm[1];
#pragma unroll
            for (int t = 0; t < 4; ++t) { const u32x4 xv = keep4(c * 128 + r - 3 + t >= 0, kxq[j][t]);
                const f32x4 x0 = {bflo(xv.x), bfhi(xv.x), bflo(xv.y), bfhi(xv.y)}, x1 = {bflo(xv.z), bfhi(xv.z), bflo(xv.w), bfhi(xv.w)};
                a0 = wvm[t][0] * x0 + a0; a1 = wvm[t][1] * x1 + a1; }
            float ak[8] = {a0[0], a0[1], a0[2], a0[3], a1[0], a1[1], a1[2], a1[3]};
#pragma unroll
            for (int e = 0; e < 8; ++e) ak[e] = ak[e] * sigmoidf_(ak[e]) * 0.125f;
            u32x4 kv; kv.x = pk2(ak[0], ak[1]); kv.y = pk2(ak[2], ak[3]); kv.z = pk2(ak[4], ak[5]); kv.w = pk2(ak[6], ak[7]);
            const u32x4 vv = vvq[j];
            const float gs = gw[r];
#pragma unroll
            for (int e = 0; e < 4; ++e) { const unsigned kw = kv[e], vw = vv[e];
                const unsigned wk = pk2(bflo(kw) * gs, bfhi(kw) * gs);
                *(LAS bf16*)(L + ML_WKT + (c8 + 2 * e) * 272 + r * 2) = (bf16)(wk & 0xffffu); *(LAS bf16*)(L + ML_WKT + (c8 + 2 * e + 1) * 272 + r * 2) = (bf16)(wk >> 16);
                *(LAS bf16*)(L + ML_VT + (c8 + 2 * e) * 272 + r * 2) = (bf16)(vw & 0xffffu); *(LAS bf16*)(L + ML_VT + (c8 + 2 * e + 1) * 272 + r * 2) = (bf16)(vw >> 16); } }
        __syncthreads();
        f32x4 CL[2];
        { const int db = w & 3;
#pragma unroll
          for (int q = 0; q < 2; ++q) { const int eb = 2 * (w >> 2) + q; CL[q] = (f32x4){0.f, 0.f, 0.f, 0.f};
#pragma unroll
              for (int ks = 0; ks < 4; ++ks) { const bf16x8 Af = *(const LAS bf16x8*)(L + ML_VT + (16 * db + l15) * 272 + (8 * g + 32 * ks) * 2);
                  const bf16x8 Bf = *(const LAS bf16x8*)(L + ML_WKT + (16 * eb + l15) * 272 + (8 * g + 32 * ks) * 2); CL[q] = PG8_MFMA(Af, Bf, CL[q]); } } }
        float nloc = 0.f;
        if (F.tid < 64) {
#pragma unroll 4
            for (int q = 0; q < 16; ++q) { const u32x4 ww = *(const LAS u32x4*)(L + ML_WKT + F.tid * 272 + q * 16);
                nloc += (bflo(ww.x) + bfhi(ww.x)) + (bflo(ww.y) + bfhi(ww.y)) + (bflo(ww.z) + bfhi(ww.z)) + (bflo(ww.w) + bfhi(ww.w)); } }
        { const int db = w & 3;
#pragma unroll
          for (int q = 0; q < 2; ++q) { const int eb = 2 * (w >> 2) + q, e = 16 * eb + l15;
#pragma unroll
              for (int i = 0; i < 4; ++i) MS[(16 * db + 4 * g + i) * 64 + e] = CL[q][i]; }
          if (F.tid < 64) MS[4096 + F.tid] = nloc;
          if (F.tid == 0) { MS[4160] = m_loc; MS[4161] = fl; } }
        __syncthreads();
    }
}
__device__ __forceinline__ void mlstm_output_unit(Frame& F, int l, int u) {
    const int bh = u >> 4, c0_ = u & 15, c = u >= 448 ? ((c0_ + 8) & 15) : (u >= 224 ? 15 - c0_ : c0_), b = bh >> 2, h = bh & 3;
    LAS unsigned char* L = F.lds;
    LAS float* nf = (LAS float*)(L + ML_NF); LAS float* Fc = (LAS float*)(L + ML_FC); LAS float* ig = (LAS float*)(L + ML_IG); LAS float* pm = (LAS float*)(L + ML_PM); LAS float* tmp = (LAS float*)(L + ML_TMP);
    const GAS bf16* P = WSP(bf16, WS_P); const GAS bf16* QKB = WSP(bf16, WS_QKB); const GAS float* GT = WSP(float, WS_GATES); GAS bf16* YC = WSP(bf16, WS_YCAT);
    const GAS float* MS = WSP(float, WS_MSUM) + (size_t)bh * 16 * MS_STRIDE;
    const GAS float* hn = INP(22) + (size_t)l * 256 + 64 * h;
    const int lane = F.lane, l15 = lane & 15, g = lane >> 4, w = F.wave;
    const size_t row0 = (size_t)b * SEQ + c * 128;
    u32x4 qvq[2], kvq[2], vvq[2];
#pragma unroll
    for (int j = 0; j < 2; ++j) { const int it = F.tid + NTHR * j, r = it >> 3, c8 = (it & 7) * 8;
        qvq[j] = *(const GAS u32x4*)(QKB + (row0 + r) * 512 + 64 * h + c8); kvq[j] = *(const GAS u32x4*)(QKB + (row0 + r) * 512 + 256 + 64 * h + c8); vvq[j] = *(const GAS u32x4*)(P + (row0 + r) * NINP + PC_VB + 64 * h + c8); }
    {
        float igv = 0.f, Fv = 0.f, pmv = -3.0e38f;
        if (F.tid < 128) { igv = GT[(row0 + F.tid) * 8 + h]; Fv = GT[(row0 + F.tid) * 8 + 4 + h];
#pragma unroll
            for (int o = 1; o < 64; o <<= 1) { const float n = shup(Fv, F.lane, o); if (lane >= o) Fv += n; }
            if (F.tid == 63) tmp[0] = Fv; }
        __syncthreads();
        if (F.tid < 128) { if (F.tid >= 64) Fv += tmp[0];
            pmv = igv - Fv;
#pragma unroll
            for (int o = 1; o < 64; o <<= 1) { const float n = shup(pmv, F.lane, o); if (lane >= o) pmv = fmaxf(pmv, n); }
            if (F.tid == 63) tmp[1] = pmv;
            ig[F.tid] = igv; Fc[F.tid] = Fv; }
        __syncthreads();
        if (F.tid >= 64 && F.tid < 128) pmv = fmaxf(pmv, tmp[1]);
        if (F.tid < 128) pm[F.tid] = pmv;
        __syncthreads();
        f32x4 C0a = {0.f, 0.f, 0.f, 0.f}, C0b = C0a; float n0v = 0.f, m0 = 0.f;
        if (c > 0) {
            if (F.tid < c) { const f32x2 sc = *(const GAS f32x2*)(MS + (size_t)F.tid * MS_STRIDE + 4160); tmp[8 + F.tid] = sc[0]; tmp[24 + F.tid] = sc[1]; }
            __syncthreads();
            float G = 0.f, mfin = -3.0e38f;
            for (int cc = c - 1; cc >= 0; --cc) { mfin = fmaxf(mfin, tmp[8 + cc] + G); G += tmp[24 + cc]; }
            mfin = fmaxf(mfin, G); m0 = mfin;
            float Gs = 0.f;
#pragma unroll 1
            for (int c4 = c - 1; c4 >= 0; c4 -= 4) {
                f32x4 la[4], lb[4]; float ln[4];
#pragma unroll
                for (int q = 0; q < 4; ++q) { const int cc = c4 - q >= 0 ? c4 - q : 0; const GAS float* ms = MS + (size_t)cc * MS_STRIDE;
                    la[q] = *(const GAS f32x4*)(ms + 8 * F.tid); lb[q] = *(const GAS f32x4*)(ms + 8 * F.tid + 4); ln[q] = ms[4096 + (F.tid & 63)]; }
                __builtin_amdgcn_sched_barrier(0);
#pragma unroll
                for (int q = 0; q < 4; ++q) { const int cc = c4 - q; float wq = 0.f;
                    if (cc >= 0) { wq = __expf(tmp[8 + cc] + Gs - mfin); Gs += tmp[24 + cc]; }
                    C0a = la[q] * wq + C0a; C0b = lb[q] * wq + C0b; n0v = ln[q] * wq + n0v; }
            }
        }
#pragma unroll
        for (int j = 0; j < 2; ++j) { const int it = F.tid + NTHR * j, r = it >> 3, c8 = (it & 7) * 8;
            const u32x4 qv = qvq[j], kv = kvq[j], vv = vvq[j];
            *(LAS u32x4*)(L + ML_QS + r * 144 + c8 * 2) = qv; *(LAS u32x4*)(L + ML_KS + r * 144 + c8 * 2) = kv;
#pragma unroll
            for (int e = 0; e < 4; ++e) { const unsigned vw = vv[e];
                *(LAS bf16*)(L + ML_VT + (c8 + 2 * e) * 272 + r * 2) = (bf16)(vw & 0xffffu); *(LAS bf16*)(L + ML_VT + (c8 + 2 * e + 1) * 272 + r * 2) = (bf16)(vw >> 16); } }
        { const int d = F.tid >> 3, e8 = (F.tid & 7) * 8;
          u32x4 cw; cw.x = pk2(C0a[0], C0a[1]); cw.y = pk2(C0a[2], C0a[3]); cw.z = pk2(C0b[0], C0b[1]); cw.w = pk2(C0b[2], C0b[3]);
          *(LAS u32x4*)(L + ML_CB + d * 144 + e8 * 2) = cw; }
        if (F.tid < 64) nf[F.tid] = n0v;
        __syncthreads();
        {
            const int t = 16 * w + l15;
            bf16x8 Qf[2];
#pragma unroll
            for (int ks = 0; ks < 2; ++ks) Qf[ks] = *(const LAS bf16x8*)(L + ML_QS + t * 144 + (8 * g + 32 * ks) * 2);
            f32x4 st[8];
#pragma unroll
            for (int sb = 0; sb < 8; ++sb) { st[sb] = (f32x4){0.f, 0.f, 0.f, 0.f};
                if (sb <= w) {
#pragma unroll
                    for (int ks = 0; ks < 2; ++ks) { const bf16x8 Kf = *(const LAS bf16x8*)(L + ML_KS + (16 * sb + l15) * 144 + (8 * g + 32 * ks) * 2); st[sb] = PG8_MFMA(Kf, Qf[ks], st[sb]); } } }
            const float Ft = Fc[t], mt = Ft + fmaxf(m0, pm[t]);
            float den = 0.f;
#pragma unroll
            for (int sb = 0; sb < 8; ++sb)
#pragma unroll
                for (int i = 0; i < 4; ++i) { const int s = 16 * sb + 4 * g + i;
                    float p = 0.f; if (sb <= w && s <= t) p = st[sb][i] * __expf(Ft - Fc[s] + ig[s] - mt);
                    st[sb][i] = p; den += p; }
            den += shx(den, F.lane, 16); den += shx(den, F.lane, 32);
            f32x4 O1[4], O2[4];
#pragma unroll
            for (int db = 0; db < 4; ++db) { O1[db] = (f32x4){0.f, 0.f, 0.f, 0.f}; O2[db] = (f32x4){0.f, 0.f, 0.f, 0.f}; }
#pragma unroll
            for (int k2 = 0; k2 < 4; ++k2) { if (2 * k2 <= w) {
                u32x4 pw; pw.x = pk2(st[2 * k2][0], st[2 * k2][1]); pw.y = pk2(st[2 * k2][2], st[2 * k2][3]); pw.z = pk2(st[2 * k2 + 1][0], st[2 * k2 + 1][1]); pw.w = pk2(st[2 * k2 + 1][2], st[2 * k2 + 1][3]);
                const bf16x8 Pf = __builtin_bit_cast(bf16x8, pw);
#pragma unroll
                for (int db = 0; db < 4; ++db) { const LAS unsigned char* vr = L + ML_VT + (16 * db + l15) * 272 + (32 * k2 + 4 * g) * 2;
                    u32x4 vw; const u32x2 v0 = *(const LAS u32x2*)vr, v1 = *(const LAS u32x2*)(vr + 32); vw.x = v0.x; vw.y = v0.y; vw.z = v1.x; vw.w = v1.y;
                    O1[db] = PG8_MFMA(__builtin_bit_cast(bf16x8, vw), Pf, O1[db]); } } }
#pragma unroll
            for (int db = 0; db < 4; ++db)
#pragma unroll
                for (int ks = 0; ks < 2; ++ks) { const bf16x8 Cfr = *(const LAS bf16x8*)(L + ML_CB + (16 * db + l15) * 144 + (8 * g + 32 * ks) * 2); O2[db] = PG8_MFMA(Cfr, Qf[ks], O2[db]); }
            const float inter = __expf(Ft + m0 - mt);
            float nqv = 0.f;
#pragma unroll
            for (int ks = 0; ks < 2; ++ks) { const u32x4 qw = __builtin_bit_cast(u32x4, Qf[ks]); const LAS float* np = nf + 32 * ks + 8 * g;
                const f32x4 n0 = *(const LAS f32x4*)np, n1 = *(const LAS f32x4*)(np + 4);
                nqv += n0[0] * bflo(qw.x) + n0[1] * bfhi(qw.x) + n0[2] * bflo(qw.y) + n0[3] * bfhi(qw.y) + n1[0] * bflo(qw.z) + n1[1] * bfhi(qw.z) + n1[2] * bflo(qw.w) + n1[3] * bfhi(qw.w); }
            nqv += shx(nqv, F.lane, 16); nqv += shx(nqv, F.lane, 32);
            den += inter * nqv;
            const float dinv = 1.0f / fmaxf(fabsf(den), __expf(-mt));
            float ss = 0.f;
#pragma unroll
            for (int db = 0; db < 4; ++db)
#pragma unroll
                for (int i = 0; i < 4; ++i) { const float hv = (O1[db][i] + inter * O2[db][i]) * dinv; O1[db][i] = hv; ss += hv * hv; }
            ss += shx(ss, F.lane, 16); ss += shx(ss, F.lane, 32);
            const float rstd = rsqrtf(ss * (1.f / 64.f) + 1e-6f);
#pragma unroll
            for (int db = 0; db < 4; ++db) { const int d0 = 16 * db + 4 * g;
                const u32x2 ov = *(const GAS u32x2*)(P + (row0 + t) * NINP + PC_OB + 64 * h + d0);
                const f32x4 hg = *(const GAS f32x4*)(hn + d0);
                const float o0 = O1[db][0] * rstd * hg[0] * sigmoidf_(bflo(ov.x)), o1 = O1[db][1] * rstd * hg[1] * sigmoidf_(bfhi(ov.x));
                const float o2 = O1[db][2] * rstd * hg[2] * sigmoidf_(bflo(ov.y)), o3 = O1[db][3] * rstd * hg[3] * sigmoidf_(bfhi(ov.y));
                u32x2 o; o.x = pk2(o0, o1); o.y = pk2(o2, o3);
                *(GAS u32x2*)(YC + (row0 + t) * 1024 + 256 + 64 * h + d0) = o; }
        }
        __syncthreads();
    }
}

constexpr int SW_KS = 0, SW_VT = 36864;
__device__ __forceinline__ void swa_unit(Frame& F, int l, int u) {
    const int nb = u & 15, kvh = (u >> 4) & 1, b = u >> 5;
    LAS unsigned char* L = F.lds;
    const GAS bf16* P = WSP(bf16, WS_P); GAS bf16* YC = WSP(bf16, WS_YCAT);
    const GAS float* qg = INP(23) + (size_t)l * 64; const GAS float* kg = INP(24) + (size_t)l * 64; const GAS float* sinkp = INP(25) + (size_t)l * 8;
    const int lane = F.lane, l15 = lane & 15, g = lane >> 4, w = F.wave;
    u32x4 kvr[4], vvr[4];
#pragma unroll
    for (int j = 0; j < 4; ++j) { const int it = F.tid + NTHR * j, kx = it >> 3, c8 = (it & 7) * 8; const int pos = (nb - 1) * 128 + kx;
        const size_t row = (size_t)b * SEQ + (pos >= 0 ? pos : 0);
        kvr[j] = *(const GAS u32x4*)(P + row * NINP + PC_KC + 64 * kvh + c8); vvr[j] = *(const GAS u32x4*)(P + row * NINP + PC_VC + 64 * kvh + c8); }
    const f32x4 kg0 = *(const GAS f32x4*)(kg + (F.tid & 7) * 8), kg1 = *(const GAS f32x4*)(kg + (F.tid & 7) * 8 + 4);
    const float kgv[8] = {kg0[0], kg0[1], kg0[2], kg0[3], kg1[0], kg1[1], kg1[2], kg1[3]};
#pragma unroll
    for (int j = 0; j < 4; ++j) { const int it = F.tid + NTHR * j, kx = it >> 3, c8 = (it & 7) * 8; const int pos = (nb - 1) * 128 + kx;
        const u32x4 kv = keep4(pos >= 0, kvr[j]), vv = keep4(pos >= 0, vvr[j]);
        float kf[8]; float ss = 0.f;
#pragma unroll
        for (int e = 0; e < 4; ++e) { kf[2 * e] = bflo(kv[e]); kf[2 * e + 1] = bfhi(kv[e]); ss += kf[2 * e] * kf[2 * e] + kf[2 * e + 1] * kf[2 * e + 1]; }
        ss += shx(ss, F.lane, 1); ss += shx(ss, F.lane, 2); ss += shx(ss, F.lane, 4);
        const float rs = rsqrtf(ss * (1.f / 64.f) + 1e-6f);
        u32x4 ko;
#pragma unroll
        for (int e = 0; e < 4; ++e) ko[e] = pk2(kf[2 * e] * rs * kgv[2 * e], kf[2 * e + 1] * rs * kgv[2 * e + 1]);
        *(LAS u32x4*)(L + SW_KS + kx * 144 + c8 * 2) = ko;
#pragma unroll
        for (int e = 0; e < 4; ++e) { *(LAS bf16*)(L + SW_VT + (c8 + 2 * e) * 528 + kx * 2) = (bf16)(vv[e] & 0xffffu); *(LAS bf16*)(L + SW_VT + (c8 + 2 * e + 1) * 528 + kx * 2) = (bf16)(vv[e] >> 16); } }
    __syncthreads();
    const int hq = 4 * kvh + (w >> 1);
    const float slope = exp2f(-(float)(hq + 1)), sink = sinkp[hq];
    float qgv[16];
    { const f32x4 a0 = *(const GAS f32x4*)(qg + 8 * g), a1 = *(const GAS f32x4*)(qg + 8 * g + 4), a2 = *(const GAS f32x4*)(qg + 32 + 8 * g), a3 = *(const GAS f32x4*)(qg + 32 + 8 * g + 4);
#pragma unroll
      for (int e = 0; e < 4; ++e) { qgv[e] = a0[e]; qgv[4 + e] = a1[e]; qgv[8 + e] = a2[e]; qgv[12 + e] = a3[e]; } }
    const GAS bf16* qp = P + ((size_t)b * SEQ + nb * 128 + 64 * (w & 1) + l15) * NINP + PC_QC + 64 * hq + 8 * g;
    u32x4 qnx[2] = {*(const GAS u32x4*)qp, *(const GAS u32x4*)(qp + 32)};
    for (int qb = 0; qb < 4; ++qb) {
        const int q0 = 64 * (w & 1) + 16 * qb, qloc = q0 + l15, kb0 = q0 >> 4;
        const size_t row = (size_t)b * SEQ + nb * 128 + qloc;
        const u32x4 qcur[2] = {qnx[0], qnx[1]};
        { const GAS bf16* qn = qp + (size_t)(16 * (qb < 3 ? qb + 1 : 3)) * NINP; qnx[0] = *(const GAS u32x4*)qn; qnx[1] = *(const GAS u32x4*)(qn + 32); }
        bf16x8 Qf[2];
        { float qf[16]; float ss = 0.f;
#pragma unroll
          for (int ks = 0; ks < 2; ++ks) { const u32x4 qv = qcur[ks];
#pragma unroll
              for (int e = 0; e < 4; ++e) { qf[8 * ks + 2 * e] = bflo(qv[e]); qf[8 * ks + 2 * e + 1] = bfhi(qv[e]); } }
#pragma unroll
          for (int e = 0; e < 16; ++e) ss += qf[e] * qf[e];
          ss += shx(ss, F.lane, 16); ss += shx(ss, F.lane, 32);
          const float rs = rsqrtf(ss * (1.f / 64.f) + 1e-6f) * 0.125f;
#pragma unroll
          for (int ks = 0; ks < 2; ++ks) { u32x4 qo;
#pragma unroll
              for (int e = 0; e < 4; ++e) { qo[e] = pk2(qf[8 * ks + 2 * e] * rs * qgv[8 * ks + 2 * e], qf[8 * ks + 2 * e + 1] * rs * qgv[8 * ks + 2 * e + 1]); }
              Qf[ks] = __builtin_bit_cast(bf16x8, qo); } }
        f32x4 st[10];
#pragma unroll
        for (int j = 0; j < 10; ++j) { const int kbc = (kb0 + j) < 15 ? (kb0 + j) : 15; st[j] = (f32x4){0.f, 0.f, 0.f, 0.f};
#pragma unroll
            for (int ks = 0; ks < 2; ++ks) { const bf16x8 Kf = *(const LAS bf16x8*)(L + SW_KS + (16 * kbc + l15) * 144 + (8 * g + 32 * ks) * 2); st[j] = PG8_MFMA(Kf, Qf[ks], st[j]); } }
        float mx = -3.0e38f;
#pragma unroll
        for (int j = 0; j < 10; ++j)
#pragma unroll
            for (int i = 0; i < 4; ++i) { const int kx = 16 * (kb0 + j) + 4 * g + i, dist = 128 + qloc - kx;
                const bool valid = dist >= 0 && dist < 128 && (nb > 0 || kx >= 128);
                const float s = valid ? st[j][i] - slope * (float)dist : -3.0e38f; st[j][i] = s; mx = fmaxf(mx, s); }
        mx = fmaxf(mx, shx(mx, F.lane, 16)); mx = fmaxf(mx, shx(mx, F.lane, 32)); mx = fmaxf(mx, sink);
        float den = 0.f;
#pragma unroll
        for (int j = 0; j < 10; ++j)
#pragma unroll
            for (int i = 0; i < 4; ++i) { const float p = st[j][i] > -1.0e38f ? __expf(st[j][i] - mx) : 0.f; st[j][i] = p; den += p; }
        den += shx(den, F.lane, 16); den += shx(den, F.lane, 32); den += __expf(sink - mx);
        const float dinv = 1.0f / den;
        f32x4 O[4];
#pragma unroll
        for (int db = 0; db < 4; ++db) O[db] = (f32x4){0.f, 0.f, 0.f, 0.f};
#pragma unroll
        for (int k2 = 0; k2 < 5; ++k2) {
            u32x4 pw; pw.x = pk2(st[2 * k2][0] * dinv, st[2 * k2][1] * dinv); pw.y = pk2(st[2 * k2][2] * dinv, st[2 * k2][3] * dinv);
            pw.z = pk2(st[2 * k2 + 1][0] * dinv, st[2 * k2 + 1][1] * dinv); pw.w = pk2(st[2 * k2 + 1][2] * dinv, st[2 * k2 + 1][3] * dinv);
            const bf16x8 Pf = __builtin_bit_cast(bf16x8, pw);
            const int kc0 = (kb0 + 2 * k2) < 15 ? (kb0 + 2 * k2) : 15, kc1 = (kb0 + 2 * k2 + 1) < 15 ? (kb0 + 2 * k2 + 1) : 15;
#pragma unroll
            for (int db = 0; db < 4; ++db) { const LAS unsigned char* vr = L + SW_VT + (16 * db + l15) * 528;
                const u32x2 v0 = *(const LAS u32x2*)(vr + (16 * kc0 + 4 * g) * 2), v1 = *(const LAS u32x2*)(vr + (16 * kc1 + 4 * g) * 2);
                u32x4 vw; vw.x = v0.x; vw.y = v0.y; vw.z = v1.x; vw.w = v1.y;
                O[db] = PG8_MFMA(__builtin_bit_cast(bf16x8, vw), Pf, O[db]); } }
#pragma unroll
        for (int db = 0; db < 4; ++db) { u32x2 o; o.x = pk2(O[db][0], O[db][1]); o.y = pk2(O[db][2], O[db][3]);
            *(GAS u32x2*)(YC + row * 1024 + 512 + 64 * hq + 16 * db + 4 * g) = o; }
    }
    __syncthreads();
}

constexpr int RT_HS = 0, RT_HSTRIDE = 2064, RT_LG = 64 * 2064, RT_CNT = RT_LG + 48 * 64 * 4, RT_BASE = RT_CNT + 128;
__device__ __forceinline__ void phase_router(Frame& F, int l) {
    LAS unsigned char* L = F.lds;
    LAS float* lg = (LAS float*)(L + RT_LG);
    LAS int* ecnt = (LAS int*)(L + RT_CNT); LAS int* ebase = (LAS int*)(L + RT_BASE); LAS float* biasT = (LAS float*)(L + RT_BASE + 256);
    const GAS float* g2 = INP(5) + (size_t)l * 1024;
    const GAS float* brg = INP(31) + (size_t)l * 4; const GAS float* bre = INP(33) + (size_t)l * 32;
    const GAS bf16* wrt = WSP(bf16, WS_WRT) + (size_t)l * 48 * 1024;
    GAS unsigned* cnt = WSP(unsigned, WS_CTL) + CW_CNT + l * 32;
    GAS int* LIST = WSP(int, WS_LIST); GAS int* ROUTE = WSP(int, WS_ROUTE);
    const int l15 = F.lane & 15, g = F.lane >> 4;
    for (int tile = F.bid; tile < NT / 64; tile += F.G) {
        const int r0 = tile * 64, b = r0 / SEQ;
        const GAS float* mb = WSP(float, WS_MOD) + ((size_t)l * 8 + b) * 6144;
        if (F.tid < 32) ecnt[F.tid] = 0;
        if (F.tid >= 64 && F.tid < 112) { const int o = F.tid - 64; biasT[o] = o < 4 ? brg[o] : (o < 36 ? bre[o - 4] : 0.f); }
        {   u32x4 xw[8][2];
            const unsigned c0 = 8 * F.lane;
#pragma unroll
            for (int rr = 0; rr < 8; ++rr)
#pragma unroll
                for (int jj = 0; jj < 2; ++jj) xw[rr][jj] = *(const GAS u32x4*)(WSP(bf16, WS_X1) + (size_t)(r0 + 8 * F.wave + rr) * 1024 + c0 + 512 * jj);
            f32x4 gsc[4], shv[4];
#pragma unroll
            for (int q = 0; q < 4; ++q) { const unsigned col = c0 + 512 * (q >> 1) + 4 * (q & 1);
                const f32x4 gg = *(const GAS f32x4*)(g2 + col), sc = *(const GAS f32x4*)(mb + 4 * 1024 + col); gsc[q] = gg * (sc + 1.0f); shv[q] = *(const GAS f32x4*)(mb + 3 * 1024 + col); }
#pragma unroll
            for (int rr = 0; rr < 8; ++rr) { const int r = 8 * F.wave + rr; const size_t row = (size_t)(r0 + r);
                f32x4 v[4]; float ss = 0.f;
#pragma unroll
                for (int q = 0; q < 4; ++q) { const u32x4 xx = xw[rr][q >> 1]; const unsigned x0 = (q & 1) ? xx.z : xx.x, x1 = (q & 1) ? xx.w : xx.y;
                    v[q] = (f32x4){bflo(x0), bfhi(x0), bflo(x1), bfhi(x1)}; ss += (v[q][0] * v[q][0] + v[q][1] * v[q][1]) + (v[q][2] * v[q][2] + v[q][3] * v[q][3]); }
                const float rstd = rsqrtf(wave_sum(ss) * (1.f / 1024.f) + 1e-6f);
                f32x4 hv[4];
#pragma unroll
                for (int q = 0; q < 4; ++q) hv[q] = v[q] * rstd * gsc[q] + shv[q];
#pragma unroll
                for (int jj = 0; jj < 2; ++jj) { u32x4 o; o.x = pk2(hv[2 * jj][0], hv[2 * jj][1]); o.y = pk2(hv[2 * jj][2], hv[2 * jj][3]); o.z = pk2(hv[2 * jj + 1][0], hv[2 * jj + 1][1]); o.w = pk2(hv[2 * jj + 1][2], hv[2 * jj + 1][3]);
                    u32x2 o8; o8.x = pk4_fp8(hv[2 * jj][0], hv[2 * jj][1], hv[2 * jj][2], hv[2 * jj][3]); o8.y = pk4_fp8(hv[2 * jj + 1][0], hv[2 * jj + 1][1], hv[2 * jj + 1][2], hv[2 * jj + 1][3]);
                    *(GAS u32x2*)(WSP(unsigned char, WS_H) + row * 1024 + c0 + 512 * jj) = o8;
                    *(LAS u32x4*)(L + RT_HS + r * RT_HSTRIDE + (c0 + 512 * jj) * 2) = o; } } }
        __syncthreads();
        { const int tb = F.wave & 3, kh = F.wave >> 2;
          f32x4 acc[3] = {(f32x4){0.f, 0.f, 0.f, 0.f}, (f32x4){0.f, 0.f, 0.f, 0.f}, (f32x4){0.f, 0.f, 0.f, 0.f}};
          const LAS unsigned char* hb = L + RT_HS + (16 * tb + l15) * RT_HSTRIDE + (512 * kh + 8 * g) * 2;
          const GAS bf16* wb = wrt + (size_t)l15 * 1024 + 512 * kh + 8 * g;
#pragma unroll
          for (int k4 = 0; k4 < 4; ++k4) {
              bf16x8 Af[4][3];
#pragma unroll
              for (int kq = 0; kq < 4; ++kq)
#pragma unroll
                  for (int ob = 0; ob < 3; ++ob) Af[kq][ob] = *(const GAS bf16x8*)(wb + (size_t)ob * 16 * 1024 + (4 * k4 + kq) * 32);
              __builtin_amdgcn_sched_barrier(0);
#pragma unroll
              for (int kq = 0; kq < 4; ++kq) { const bf16x8 Bf = *(const LAS bf16x8*)(hb + (4 * k4 + kq) * 64);
#pragma unroll
                  for (int ob = 0; ob < 3; ++ob) acc[ob] = PG8_MFMA(Af[kq][ob], Bf, acc[ob]); }
              __builtin_amdgcn_sched_barrier(0); }
          if (kh == 1) {
#pragma unroll
              for (int ob = 0; ob < 3; ++ob)
#pragma unroll
                  for (int i = 0; i < 4; ++i) lg[(16 * ob + 4 * g + i) * 64 + 16 * tb + l15] = acc[ob][i]; }
          __syncthreads();
          if (kh == 0) {
#pragma unroll
              for (int ob = 0; ob < 3; ++ob)
#pragma unroll
                  for (int i = 0; i < 4; ++i) { const int o = 16 * ob + 4 * g + i; const float bias = biasT[o];
                      lg[o * 64 + 16 * tb + l15] += acc[ob][i] + bias; } } }
        __syncthreads();
        int e1 = 0, e2 = 0, li1 = 0, li2 = 0; float w1 = 0.f, w2 = 0.f;
        if (F.tid < 64) { float lr[36];
#pragma unroll
            for (int j = 0; j < 36; ++j) lr[j] = lg[j * 64 + F.tid];
            int gi = 0; float gm = lr[0];
#pragma unroll
            for (int j = 1; j < 4; ++j) if (lr[j] > gm) { gm = lr[j]; gi = j; }
            float gs = 0.f;
#pragma unroll
            for (int j = 0; j < 4; ++j) gs += __expf(lr[j] - gm);
            const float gtop = 1.0f / gs;
            float er[8];
#pragma unroll
            for (int j = 0; j < 8; ++j) er[j] = gi == 0 ? lr[4 + j] : (gi == 1 ? lr[12 + j] : (gi == 2 ? lr[20 + j] : lr[28 + j]));
            int i1 = 0; float m1 = er[0];
#pragma unroll
            for (int j = 1; j < 8; ++j) if (er[j] > m1) { m1 = er[j]; i1 = j; }
            int i2 = -1; float m2 = -3.0e38f;
#pragma unroll
            for (int j = 0; j < 8; ++j) if (j != i1 && er[j] > m2) { m2 = er[j]; i2 = j; }
            const float x2 = __expf(m2 - m1); w1 = gtop / (1.0f + x2); w2 = gtop * x2 / (1.0f + x2);
            e1 = 8 * gi + i1; e2 = 8 * gi + i2;
            li1 = __hip_atomic_fetch_add(&ecnt[e1], 1, __ATOMIC_RELAXED, __HIP_MEMORY_SCOPE_WORKGROUP); li2 = __hip_atomic_fetch_add(&ecnt[e2], 1, __ATOMIC_RELAXED, __HIP_MEMORY_SCOPE_WORKGROUP); }
        __syncthreads();
        if (F.tid < 32) WSP(int, WS_CNTT)[((size_t)l * 256 + tile) * 32 + F.tid] = ecnt[F.tid];
        if (F.tid < 64) { const int tok = r0 + F.tid;
            GAS int* rt = ROUTE + (size_t)tok * 8; rt[0] = e1; rt[1] = e2; rt[2] = li1; rt[3] = li2; rt[4] = __float_as_int(w1); rt[5] = __float_as_int(w2); }
        __syncthreads();
    }
}
__device__ __forceinline__ void phase_scatter(Frame& F, int l) {
    LAS int* part = (LAS int*)F.lds;
    LAS int* base = part + 1024;
    const GAS int* CT = WSP(int, WS_CNTT) + (size_t)l * 256 * 32;
    GAS int* LIST = WSP(int, WS_LIST); GAS int* ROUTE = WSP(int, WS_ROUTE);
    for (int tile = F.bid; tile < NT / 64; tile += F.G) {
        { const int e = F.tid & 31, pt = F.tid >> 5; int sb = 0, st = 0;
          int cq[16];
#pragma unroll
          for (int q = 0; q < 16; ++q) cq[q] = CT[(16 * pt + q) * 32 + e];
          __builtin_amdgcn_sched_barrier(0);
#pragma unroll
          for (int q = 0; q < 16; ++q) { const int t2 = 16 * pt + q; const int c = cq[q]; st += c; sb += (t2 < tile) ? c : 0; }
          part[pt * 32 + e] = sb; part[512 + pt * 32 + e] = st; }
        __syncthreads();
        if (F.tid < 32) { int sb = 0, st = 0;
#pragma unroll
            for (int q = 0; q < 16; ++q) { sb += part[q * 32 + F.tid]; st += part[512 + q * 32 + F.tid]; }
            base[F.tid] = sb;
            if (tile == 0) WSP(unsigned, WS_CTL)[CW_CNT + l * 32 + F.tid] = (unsigned)st; }
        __syncthreads();
        if (F.tid < 64) { const int tok = tile * 64 + F.tid; GAS int* rt = ROUTE + (size_t)tok * 8;
            const u32x4 r4 = *(const GAS u32x4*)rt; const int e1 = (int)r4.x, e2 = (int)r4.y, p1 = base[e1] + (int)r4.z, p2 = base[e2] + (int)r4.w;
            LIST[e1 * NT + p1] = tok; LIST[e2 * NT + p2] = tok; rt[6] = p1; rt[7] = p2; }
        __syncthreads();
    }
}

#ifndef MK_ONE_LAUNCH
#define MK_ONE_LAUNCH 1
#endif
#ifndef MK_SIMPLE_GEMM
#define MK_SIMPLE_GEMM 0
#endif
#if MK_SIMPLE_GEMM
#define RUN_GEMM(EPI, SCHED, GATHER, g, S, E) pg8::gemm_simple<EPI, SCHED, GATHER>(F.tid, g, S, E)
#else
#define RUN_GEMM(EPI, SCHED, GATHER, g, S, E) pg8::gemm_phase<EPI, SCHED, GATHER>(F.tid, F.lds, g, S, E)
#endif
__global__ void __launch_bounds__(NTHR, 2) fwd(Args args) {
    extern __shared__ __attribute__((aligned(16))) unsigned char lds_raw[];
    Frame F;
    F.lds = (LAS unsigned char*)lds_raw;
    const int wave0 = __builtin_amdgcn_readfirstlane((int)threadIdx.x >> 6);
    F.wave = wave0; F.lane = (int)__builtin_amdgcn_mbcnt_hi(~0u, __builtin_amdgcn_mbcnt_lo(~0u, 0u)); F.tid = wave0 * 64 + F.lane; F.G = gridDim.x; F.bid = blockIdx.x;
    F.in = args.in; F.out = (GAS float*)args.out; F.ws = args.ws;
    volatile LAS unsigned* MISC = (volatile LAS unsigned*)(F.lds + LDS_MISC);
    if (F.tid < 64) MISC[F.tid] = 0u;
    __syncthreads();
    const int lo = args.ph_lo, hi = args.ph_hi;
    XcdBarrier bar; bar.bar = (unsigned*)(WSP(unsigned, WS_CTL) + CW_BAR); bar.x = 0; bar.st = MISC + 8;
    if (hi - lo > 1) bar = xcd_barrier_post((unsigned*)(WSP(unsigned, WS_CTL) + CW_BAR), MISC + 8, F.tid);
#ifndef MK_PH_MASK
#define MK_PH_MASK 0xfff
#endif
#define IN(k) (opaque_s(lo) <= (k) && (k) < opaque_s(hi))
#define EN(j) (((MK_PH_MASK) >> (j)) & 1)
#ifndef MK_REPS
#define MK_REPS 1,1,1,1,1,1,1,1,1,1,1,1
#endif
    constexpr int REPS[12] = {MK_REPS};
#define REFRESH() do { int l_; asm volatile("v_mbcnt_lo_u32_b32 %0, -1, 0\n\tv_mbcnt_hi_u32_b32 %0, -1, %0" : "=v"(l_)); F.lane = l_; F.wave = wave0; F.tid = wave0 * 64 + l_; } while (0)
#define SEAM(k) do { if ((k) + 1 < opaque_s(hi)) { REFRESH(); xcd_barrier(bar, F.tid); } } while (0)
    if (EN(0) && IN(0)) for (int rep = 0; rep < REPS[0]; ++rep) { REFRESH(); p0_prologue(F); REFRESH(); convert_layer(F, 0, F.bid, F.G); SEAM(0); }
    for (int l = 0; l < DEPTH; ++l) {
        const int pb = 1 + l * NPH_LAYER;
        if (EN(1) && IN(pb + 0)) for (int rep = 0; rep < REPS[1]; ++rep) { REFRESH(); phase_norm1(F, l); SEAM(pb + 0); }
        if (EN(2) && IN(pb + 1)) for (int rep = 0; rep < REPS[2]; ++rep) { REFRESH();
            { pg8::Gemm g{WSP(bf16, WS_H), WSP(bf16, WS_WTIN) + (size_t)l * NINP * 1024, 1024, 1024, nullptr};
              pg8::SchedPlain S{64, 12, 16, F.G, F.bid}; pg8::EpiStoreBf16 E{WSP(bf16, WS_P), NINP, 1.f};
              RUN_GEMM(pg8::EpiStoreBf16, pg8::SchedPlain, false, g, S, E); }
            REFRESH();
            { pg8::Gemm g{(const GAS bf16*)WSP(unsigned char, WS_H8), (const GAS bf16*)(WSP(unsigned char, WS_WTIN8) + (size_t)l * 3072 * 1024), 1024, 1024, nullptr};
              pg8::SchedPlain S{64, 12, 8, F.G, F.bid}; pg8::EpiGateU8 E{WSP(unsigned char, WS_P) + 2 * PC_GATE, 1.f / F8S_WIN};
              pg8::gemm_phase<pg8::EpiGateU8, pg8::SchedPlain, false, 1>(F.tid, F.lds, g, S, E); }
            SEAM(pb + 1); }
        if (EN(4) && IN(pb + 3)) for (int rep = 0; rep < REPS[4]; ++rep) {
            REFRESH(); phase_prep(F, l);
            VM_WAIT(); __syncthreads();
            REFRESH();
            for (int gq = F.bid; gq < 32 * SC_NCH / 4; gq += F.G) scan_local_block(F, l, gq);
            for (int u = F.bid; u < 512; u += F.G) mlstm_summary_unit(F, l, u);
            for (int u = F.bid; u < 256; u += F.G) swa_unit(F, l, u);
            REFRESH(); xcd_barrier(bar, F.tid);
            REFRESH();
            if (F.bid < 32) scan_combine_unit(F, l, F.bid);
            else for (int u = F.bid - 32; u < 512; u += F.G - 32) mlstm_output_unit(F, l, u);
            if (F.bid >= 32) {
                REFRESH();
                pg8::Gemm g{WSP(bf16, WS_YCAT), WSP(bf16, WS_WTBR) + (size_t)l * 1024 * 1024, 1024, 1024, nullptr};
                pg8::SchedMerge S{F.G - 32, F.G - 1 - F.bid, 2, 1, 0}; pg8::EpiMerge E{WSP(bf16, WS_MERGED), WSP(bf16, WS_P)};
                RUN_GEMM(pg8::EpiMerge, pg8::SchedMerge, false, g, S, E); }
            SEAM(pb + 3); }
        if (EN(6) && IN(pb + 5)) for (int rep = 0; rep < REPS[6]; ++rep) { REFRESH();
            pg8::Gemm g{WSP(bf16, WS_YCAT), WSP(bf16, WS_WTBR) + (size_t)l * 1024 * 1024, 1024, 1024, nullptr};
            pg8::SchedMergeAB S{F.G, F.bid}; pg8::EpiMergeAB E{WSP(bf16, WS_MERGED), WSP(bf16, WS_P)};
            RUN_GEMM(pg8::EpiMergeAB, pg8::SchedMergeAB, false, g, S, E);
            SEAM(pb + 5); }
        if (EN(7) && IN(pb + 6)) for (int rep = 0; rep < REPS[7]; ++rep) { REFRESH();
            pg8::Gemm g{WSP(bf16, WS_MERGED), WSP(bf16, WS_WTOUT) + (size_t)l * 1024 * 1024, 1024, 1024, nullptr};
            pg8::SchedPlain S{64, 4, 16, F.G, F.bid};
            pg8::EpiRes E{l == 0 ? INP(0) : (const GAS float*)nullptr, WSP(bf16, WS_XA), WSP(bf16, WS_X1), WSP(float, WS_MOD) + (size_t)l * 8 * 6144 + 2048};
            RUN_GEMM(pg8::EpiRes, pg8::SchedPlain, false, g, S, E);
            SEAM(pb + 6); }
        if (EN(8) && IN(pb + 7)) for (int rep = 0; rep < REPS[8]; ++rep) { REFRESH(); phase_router(F, l); SEAM(pb + 7); }
        if (EN(9) && IN(pb + 8)) for (int rep = 0; rep < REPS[9]; ++rep) {
            REFRESH(); phase_scatter(F, l); REFRESH(); xcd_barrier(bar, F.tid);
            REFRESH(); LAS int* tp = (LAS int*)(F.lds + 131072); build_tp(F, l, tp);
            pg8::Gemm g{WSP(bf16, WS_H), (const GAS bf16*)(WSP(unsigned char, WS_WTEIN) + (size_t)l * NEXP * 1024 * 1024), 1024, 1024, WSP(int, WS_LIST)};
            pg8::SchedMoE S{tp, F.G, F.bid, 8, 1}; pg8::EpiAct E{WSP(unsigned char, WS_ACT), 1.f / F8S_EIN};
            pg8::gemm_phase<pg8::EpiAct, pg8::SchedMoE, true, 1>(F.tid, F.lds, g, S, E);
            SEAM(pb + 8); }
        if (EN(10) && IN(pb + 9)) for (int rep = 0; rep < REPS[10]; ++rep) {
            REFRESH(); LAS int* tp = (LAS int*)(F.lds + 131072); build_tp(F, l, tp);
            pg8::Gemm g{WSP(bf16, WS_ACT), (const GAS bf16*)(WSP(unsigned char, WS_WTEOUT) + (size_t)l * NEXP * 1024 * 512), 512, 512, nullptr};
            pg8::SchedMoE S{tp, F.G, F.bid, 4, 0}; pg8::EpiStoreFp8 E{WSP(unsigned char, WS_YB), 1024, 1.f / F8S_EOUT};
            pg8::gemm_phase<pg8::EpiStoreFp8, pg8::SchedMoE, false, 1>(F.tid, F.lds, g, S, E);
            SEAM(pb + 9); }
    }
    if (EN(11) && IN(NPHASES - 1)) { REFRESH(); phase_final(F); }
#undef IN
#undef SEAM
}

extern "C" void kernel_launch(void* const* d_in, const int* in_sizes, int n_in, void* d_out, int out_size, void* d_ws, size_t ws_size, hipStream_t stream) {
    static int grid = 0;
    if (grid == 0) {
        if (n_in != 36 || in_sizes[0] != NT * D || out_size != NT * D || ws_size < WS_END) {
            fprintf(stderr, "kernel_launch: unexpected shapes (n_in %d, in0 %d, out %d, ws %zu); nothing launched\n", n_in, n_in > 0 ? in_sizes[0] : -1, out_size, ws_size); grid = -1; return; }
        int dev = 0, cus = 0, per_cu = 0;
        if (hipGetDevice(&dev) != hipSuccess || hipDeviceGetAttribute(&cus, hipDeviceAttributeMultiprocessorCount, dev) != hipSuccess) { grid = -1; return; }
        if (hipFuncSetAttribute((const void*)fwd, hipFuncAttributeMaxDynamicSharedMemorySize, LDS_BYTES) != hipSuccess) { fprintf(stderr, "kernel_launch: hipFuncSetAttribute failed\n"); grid = -1; return; }
        if (hipOccupancyMaxActiveBlocksPerMultiprocessor(&per_cu, (const void*)fwd, NTHR, LDS_BYTES) != hipSuccess || per_cu < 1) fprintf(stderr, "kernel_launch: occupancy query reports %d\n", per_cu);
        (void)hipGetLastError();
        grid = cus;
        if (grid != 256) fprintf(stderr, "kernel_launch: %d CUs; this build is laid out for 256\n", grid);
    }
    if (grid < 0) return;
    (void)hipMemsetAsync((char*)d_ws + WS_CTL, 0, CTL_ZERO_BYTES, stream);
    Args a{};
    for (int i = 0; i < 36; ++i) a.in[i] = (const float*)d_in[i];
    a.out = (float*)d_out; a.ws = (unsigned char*)d_ws;
#if MK_ONE_LAUNCH
    a.ph_lo = 0; a.ph_hi = NPHASES;
    hipLaunchKernelGGL(fwd, dim3(grid), dim3(NTHR), LDS_BYTES, stream, a);
#else
    for (int p = 0; p < NPHASES; ++p) { a.ph_lo = p; a.ph_hi = p + 1; hipLaunchKernelGGL(fwd, dim3(grid), dim3(NTHR), LDS_BYTES, stream, a); }
#endif
}
```

```cpp
#include <hip/hip_runtime.h>
#include <cstdio>
#include <cstdint>

#define GAS __attribute__((address_space(1)))
#define LAS __attribute__((address_space(3)))
typedef unsigned short bf16;
typedef short bf16x8 __attribute__((ext_vector_type(8)));
typedef short s16x4 __attribute__((ext_vector_type(4)));
typedef float f32x4 __attribute__((ext_vector_type(4)));
typedef float f32x2 __attribute__((ext_vector_type(2)));
typedef unsigned u32x4 __attribute__((ext_vector_type(4)));
typedef unsigned u32x2 __attribute__((ext_vector_type(2)));
typedef __bf16 bf16x2_t __attribute__((ext_vector_type(2)));

constexpr int D = 1024, BATCH = 8, SEQ = 2048, DEPTH = 4, NT = BATCH * SEQ;
constexpr int NIN = 5896, NINP = 6144;
constexpr int NEXP = 32, DEXP = 512;
constexpr float F8S_EIN = 32.f, F8S_EOUT = 16.f, F8S_WIN = 32.f;
constexpr int PC_QB = 1024, PC_KB = 1280, PC_VB = 1536, PC_OB = 1792, PC_QC = 2048, PC_KC = 2560, PC_VC = 2688, PC_IB = 2816, PC_FB = 2820, PC_GATE = 3072;
constexpr int NPH_LAYER = 10;
constexpr int NPHASES = 1 + DEPTH * NPH_LAYER + 1;

constexpr size_t MiB = 1u << 20;
constexpr size_t WS_CTL = 0, CTL_ZERO_BYTES = 1 * MiB;
constexpr size_t WS_MOD = 1 * MiB;
constexpr size_t WS_WTIN = 2 * MiB;
constexpr size_t WS_WTBR = 50 * MiB;
constexpr size_t WS_WTOUT = 58 * MiB;
constexpr size_t WS_WTEIN = 66 * MiB;
constexpr size_t WS_WTEOUT = 322 * MiB;
constexpr size_t WS_XA = 450 * MiB;
constexpr size_t WS_X1 = 514 * MiB;
constexpr size_t WS_H = 578 * MiB;
constexpr size_t WS_P = 610 * MiB;
constexpr size_t WS_RW = 802 * MiB;
constexpr size_t WS_YCAT = 946 * MiB;
constexpr size_t WS_MERGED = 978 * MiB;
constexpr size_t WS_QKB = 1010 * MiB;
constexpr size_t WS_GATES = 1026 * MiB;
constexpr size_t WS_ROUTE = 1027 * MiB;
constexpr size_t WS_CNTT = 1027 * MiB + 512 * 1024;
constexpr size_t WS_LIST = 1028 * MiB;
constexpr size_t WS_ACT = 1030 * MiB;
constexpr size_t WS_YB = 1072 * MiB;
constexpr size_t WS_LORA = 1154 * MiB;
constexpr size_t WS_WRT = 1155 * MiB;
constexpr size_t WS_PT = 1156 * MiB;
constexpr size_t WS_UT = 1210 * MiB + 320 * MiB;
constexpr size_t WS_ZB = 1168 * MiB;
constexpr size_t WS_YL = 1176 * MiB;
constexpr size_t WS_MSUM = 1192 * MiB;
constexpr size_t WS_MST = 1201 * MiB;
constexpr size_t WS_RWS = 1210 * MiB;
constexpr size_t WS_WTIN8 = 1546 * MiB;
constexpr size_t WS_H8 = 1558 * MiB;
constexpr size_t WS_END = 1574 * MiB;
constexpr int RW_W = 0, RW_K = 1, RW_AV = 2, RW_BV = 3, RW_R = 4, RW_V = 5, RW_G = 6, RW_BONUS = 7, RW_Y = 8;
constexpr size_t RW_STRIDE = (size_t)NT * 256;
constexpr int CW_BAR = 4096;
constexpr int CW_CNT = 16384;
constexpr int LDS_BYTES = 155648;
constexpr int LDS_MISC = 155648 - 256;

__device__ __forceinline__ float bf2f(unsigned v) { return __uint_as_float(v << 16); }
__device__ __forceinline__ unsigned pk2(float lo, float hi) { f32x2 v = {lo, hi}; bf16x2_t b = __builtin_convertvector(v, bf16x2_t); return __builtin_bit_cast(unsigned, b); }
__device__ __forceinline__ float bflo(unsigned w) { return __uint_as_float(w << 16); }
__device__ __forceinline__ float bfhi(unsigned w) { return __uint_as_float(w & 0xffff0000u); }
__device__ __forceinline__ float sigmoidf_(float x) { return __builtin_amdgcn_rcpf(1.0f + __expf(-x)); }
template <int CTRL> __device__ __forceinline__ float dpp_f(float x) { return __builtin_bit_cast(float, __builtin_amdgcn_update_dpp(0, __builtin_bit_cast(int, x), CTRL, 0xf, 0xf, false)); }
__device__ __forceinline__ float row16_sum(float x) {
    x += dpp_f<0xB1>(x);
    x += dpp_f<0x4E>(x);
    x += dpp_f<0x124>(x);
    x += dpp_f<0x128>(x);
    return x;
}
__device__ __forceinline__ int opaque_s(int k) { asm volatile("" : "+s"(k)); return k; }
__device__ __forceinline__ unsigned char* opaque_p(unsigned char* p) { asm volatile("" : "+s"(p)); return p; }
__device__ __forceinline__ float wave_sum(float v) {
    v = row16_sum(v);
    const float s0 = __builtin_bit_cast(float, __builtin_amdgcn_readlane(__builtin_bit_cast(int, v), 0)), s1 = __builtin_bit_cast(float, __builtin_amdgcn_readlane(__builtin_bit_cast(int, v), 16));
    const float s2 = __builtin_bit_cast(float, __builtin_amdgcn_readlane(__builtin_bit_cast(int, v), 32)), s3 = __builtin_bit_cast(float, __builtin_amdgcn_readlane(__builtin_bit_cast(int, v), 48));
    return (s0 + s1) + (s2 + s3);
}
__device__ __forceinline__ float shx(float x, int lane, int m) { return __builtin_bit_cast(float, __builtin_amdgcn_ds_bpermute((lane ^ m) << 2, __builtin_bit_cast(int, x))); }
__device__ __forceinline__ float shup(float x, int lane, int o) { return __builtin_bit_cast(float, __builtin_amdgcn_ds_bpermute((lane >= o ? lane - o : lane) << 2, __builtin_bit_cast(int, x))); }
typedef int v8i32 __attribute__((ext_vector_type(8)));
__device__ __forceinline__ unsigned pk4_fp8(float a, float b, float c, float d) { int p = __builtin_amdgcn_cvt_pk_fp8_f32(a, b, 0, false); p = __builtin_amdgcn_cvt_pk_fp8_f32(c, d, p, true); return (unsigned)p; }
__device__ __forceinline__ f32x4 zero4() { float z; asm volatile("v_mov_b32 %0, 0" : "=v"(z)); return (f32x4){z, z, z, z}; }
__device__ __forceinline__ u32x4 keep4(bool c, u32x4 v) { return (u32x4){c ? v.x : 0u, c ? v.y : 0u, c ? v.z : 0u, c ? v.w : 0u}; }
__device__ __forceinline__ u32x2 keep2(bool c, u32x2 v) { return (u32x2){c ? v.x : 0u, c ? v.y : 0u}; }
#define LDS_WAIT() asm volatile("s_waitcnt lgkmcnt(0)" ::: "memory")
#define VM_WAIT() asm volatile("s_waitcnt vmcnt(0)" ::: "memory")

#define XB_TMO      128
#define XB_XCNT(j)  (256  + 64 * (j))
#define XB_XSUB(j)  (1280 + 64 * (j))
#define XB_XGEN(j)  (2304 + 64 * (j))
#define XB_TOP      3328
#define XB_TOPGEN   3392
#define XCD_BAR_WORDS 3456
#define XB_SPIN_CAP (1u << 18)
__device__ __forceinline__ unsigned xb_ld(unsigned* p)              { return __hip_atomic_load(p, __ATOMIC_RELAXED, __HIP_MEMORY_SCOPE_AGENT); }
__device__ __forceinline__ unsigned xb_add(unsigned* p, unsigned v) { return __hip_atomic_fetch_add(p, v, __ATOMIC_RELAXED, __HIP_MEMORY_SCOPE_AGENT); }
__device__ __forceinline__ unsigned xb_xcc_id() { return (unsigned)__builtin_amdgcn_s_getreg((3 << 11) | 20) & 0xFu; }
#define XB_SPIN(cond, bar) do { unsigned _sp = 0; while (cond) { __builtin_amdgcn_s_sleep(1); \
    if ((++_sp & 255u) == 0u) { if (xb_ld(&(bar)[XB_TMO])) break; if (_sp > XB_SPIN_CAP) { atomicAdd(&(bar)[XB_TMO], 1u); break; } } } } while (0)
struct XcdBarrier { unsigned* bar; unsigned x; volatile LAS unsigned* st; };
__device__ __forceinline__ XcdBarrier xcd_barrier_post(unsigned* bar, volatile LAS unsigned* st, int tid) {
    XcdBarrier b; b.bar = bar; b.x = xb_xcc_id(); b.st = st;
    if (tid == 0) (void)xb_add(&bar[XB_XCNT(b.x)], 1u);
    return b;
}
__device__ __forceinline__ void xcd_barrier_complete(unsigned* bar, unsigned x, unsigned& nloc, unsigned& nx) {
    const unsigned G = gridDim.x * gridDim.y * gridDim.z;
    unsigned sum, cnt, mine, sp = 0u;
    for (;;) {
        sum = 0u; cnt = 0u; mine = 0u;
#pragma unroll
        for (unsigned j = 0; j < 16; ++j) { const unsigned c = xb_ld(&bar[XB_XCNT(j)]); sum += c; cnt += (c > 0u) ? 1u : 0u; mine = (j == x) ? c : mine; }
        if (sum == G) break;
        __builtin_amdgcn_s_sleep(1);
        if ((++sp & 255u) == 0u) { if (xb_ld(&bar[XB_TMO])) break; if (sp > XB_SPIN_CAP) { atomicAdd(&bar[XB_TMO], 1u); break; } }
    }
    nloc = mine > 0u ? mine : 1u; nx = cnt > 0u ? cnt : 1u;
}
__device__ __forceinline__ void xcd_barrier(const XcdBarrier& b, int tid) {
    asm volatile("s_waitcnt vmcnt(0)" ::: "memory");
    __syncthreads();
    if (tid == 0) {
        unsigned* bar = b.bar;
        __builtin_amdgcn_s_waitcnt(0);
        unsigned nloc = b.st[0], nx = b.st[1];
        if (nloc == 0u) { xcd_barrier_complete(bar, b.x, nloc, nx); b.st[0] = nloc; b.st[1] = nx; }
        const unsigned old = xb_add(&bar[XB_XSUB(b.x)], 1u);
        const unsigned gen = old / nloc;
        if (old + 1u == (gen + 1u) * nloc) {
            __builtin_amdgcn_fence(__ATOMIC_RELEASE, "agent");
            asm volatile("s_waitcnt vmcnt(0)" ::: "memory");
            const unsigned og = xb_add(&bar[XB_TOP], 1u);
            const unsigned tg = og / nx;
            if (og + 1u == (tg + 1u) * nx) xb_add(&bar[XB_TOPGEN], 1u);
            else XB_SPIN(xb_ld(&bar[XB_TOPGEN]) == tg, bar);
            xb_add(&bar[XB_XGEN(b.x)], 1u);
            __builtin_amdgcn_fence(__ATOMIC_ACQUIRE, "agent");
            asm volatile("s_waitcnt vmcnt(0)" ::: "memory");
        } else {
            XB_SPIN(xb_ld(&bar[XB_XGEN(b.x)]) == gen, bar);
            __builtin_amdgcn_fence(__ATOMIC_ACQUIRE, "agent");
            asm volatile("s_waitcnt vmcnt(0)" ::: "memory");
        }
    }
    __syncthreads();
}

namespace pg8 {
constexpr int BM = 256, BK = 64, HALF = 128, HTB = HALF * BK * 2, STAGE_BYTES = 8 * HTB, NXCD = 8, WGM = 8;
__host__ __device__ __forceinline__ int lds_byte(int r, int c) { const int st = (r >> 4) * 2 + (c >> 5), rr = r & 15, cc = c & 31, ob = rr * 64 + cc * 2; return st * 1024 + (ob ^ (((ob >> 9) & 1) << 5)); }
__host__ __device__ __forceinline__ void stage_rc(int b, int& R, int& C) { const int st = b / 1024, sb = b % 1024, swz = sb ^ (((sb >> 9) & 1) << 5); R = (st >> 1) * 16 + swz / 64; C = (st & 1) * 32 + (swz % 64) / 2; }
__host__ __device__ __forceinline__ int perm32(int rho) { const int n = rho >> 4, i = rho & 15; return 8 * (i >> 2) + 4 * n + (i & 3); }

struct u32x4x2 { u32x4 a, b; };
struct Unit { int a0, b0, k0, nk, pm, pn, aux, cnt; };
struct Gemm { const GAS bf16* A; const GAS bf16* Bt; int lda, ldb; const GAS int* list; };

__device__ __forceinline__ void tile_of(int L, int nM, int nN, int& pm, int& pn) {
    const int nwg = nM * nN; int wgid = L;
    { const int q = nwg / NXCD, r = nwg % NXCD, xcd = wgid % NXCD, off = wgid / NXCD; wgid = (xcd < r ? xcd * (q + 1) : r * (q + 1) + (xcd - r) * q) + off; }
    const int nig = WGM * nN, gid = wgid / nig, fm = gid * WGM, gsz = (nM - fm) < WGM ? (nM - fm) : WGM;
    pm = fm + ((wgid % nig) % gsz); pn = (wgid % nig) / gsz;
}
struct SchedPlain {
    int nM, nN, nk, G, c;
    __device__ __forceinline__ bool next(int i, Unit& u) const {
        const long L = (long)i * G + c; if (L >= (long)nM * nN) return false;
        tile_of((int)L, nM, nN, u.pm, u.pn); u.a0 = u.pm * BM; u.b0 = u.pn * BM; u.k0 = 0; u.nk = nk; u.aux = 0; u.cnt = BM; return true;
    }
};
struct SchedMerge {
    int G, c, s0, ns, prev0;
    __device__ __forceinline__ bool next(int i, Unit& u) const {
        const int j = i / ns, seg = s0 + (i - ns * j); const long L = (long)j * G + c; if (L >= 256) return false;
        tile_of((int)L, 64, 4, u.pm, u.pn); u.a0 = u.pm * BM; u.b0 = u.pn * BM; u.k0 = seg == 0 ? 0 : (seg == 1 ? 256 : 512); u.nk = seg == 2 ? 8 : 4; u.aux = seg | ((prev0 || seg != s0) ? 16 : 0); u.cnt = BM; return true;
    }
    __device__ __forceinline__ void ready(const Unit&, int) const {}
};
struct SchedMoE {
    const LAS int* tp;
    int G, c, nk, gather;
    __device__ __forceinline__ bool next(int i, Unit& u) const {
        const int cv = (G % 8 == 0) ? (c % 8) * (G / 8) + c / 8 : c;
        const long L = (long)i * G + cv; const int TT = tp[32]; if (L >= (long)TT * 4) return false;
        const int rt = (int)(L >> 2), pn = (int)(L & 3); const int e = (int)((const LAS unsigned char*)(tp + 72))[rt];
        const int tile = rt - tp[e], cn = tp[33 + e] - tile * BM;
        u.pm = rt; u.pn = pn; u.a0 = gather ? (e * NT + tile * BM) : rt * BM; u.b0 = e * 1024 + pn * BM; u.k0 = 0; u.nk = nk; u.aux = e; u.cnt = cn < BM ? cn : BM; return true;
    }
};

#define PG8_MFMA(a, b, c) __builtin_amdgcn_mfma_f32_16x16x32_bf16(a, b, c, 0, 0, 0)

template <class Epi, class Sched, bool GATHER>
__device__ __forceinline__ void gemm_simple(int tid_in, const Gemm g, const Sched& S, const Epi& E) {
    int tid_ = tid_in; asm volatile("" : "+v"(tid_));
    const int tid = tid_, wid = __builtin_amdgcn_readfirstlane(tid >> 6), lane = tid & 63, wr = wid >> 2, wc = wid & 3, fr = lane & 15, fq = lane >> 4;
    for (int ui = 0;; ++ui) {
        Unit u; if (!S.next(ui, u)) break;
        f32x4 acc[2][2][4][2];
#pragma unroll
        for (int a = 0; a < 2; ++a)
#pragma unroll
            for (int b = 0; b < 2; ++b)
#pragma unroll
                for (int m = 0; m < 4; ++m)
#pragma unroll
                    for (int n = 0; n < 2; ++n) acc[a][b][m][n] = zero4();
        const GAS bf16* ap[2][4]; const GAS bf16* bp[2][2];
#pragma unroll
        for (int ai = 0; ai < 2; ++ai)
#pragma unroll
            for (int m = 0; m < 4; ++m) { const int r = ai * HALF + wr * 64 + m * 16 + fr; int row;
                if (GATHER) row = (r < u.cnt) ? g.list[u.a0 + r] : 0; else row = u.a0 + r;
                ap[ai][m] = g.A + (size_t)row * g.lda + u.k0 + 8 * fq; }
#pragma unroll
        for (int bj = 0; bj < 2; ++bj)
#pragma unroll
            for (int n = 0; n < 2; ++n) { const int rho = 16 * n + fr; const int row = u.b0 + bj * HALF + wc * 32 + (Epi::PERM ? perm32(rho) : rho);
                bp[bj][n] = g.Bt + (size_t)row * g.ldb + u.k0 + 8 * fq; }
        for (int kk = 0; kk < u.nk * BK; kk += 32) {
            bf16x8 Bf[2][2];
#pragma unroll
            for (int bj = 0; bj < 2; ++bj)
#pragma unroll
                for (int n = 0; n < 2; ++n) Bf[bj][n] = *(const GAS bf16x8*)(bp[bj][n] + kk);
#pragma unroll
            for (int ai = 0; ai < 2; ++ai) {
                bf16x8 Af[4];
#pragma unroll
                for (int m = 0; m < 4; ++m) Af[m] = *(const GAS bf16x8*)(ap[ai][m] + kk);
#pragma unroll
                for (int bj = 0; bj < 2; ++bj)
#pragma unroll
                    for (int m = 0; m < 4; ++m)
#pragma unroll
                        for (int n = 0; n < 2; ++n) acc[ai][bj][m][n] = PG8_MFMA(Bf[bj][n], Af[m], acc[ai][bj][m][n]);
            }
        }
        E(acc, u, wr, wc, fr, fq);
    }
}

template <class Epi, class Sched, bool GATHER, int ES = 2>
__device__ __forceinline__ void gemm_phase(int tid_in, LAS unsigned char* lds, const Gemm g, const Sched& S, const Epi& E) {
    int tid_ = tid_in; asm volatile("" : "+v"(tid_));
    const int tid = tid_, wid = __builtin_amdgcn_readfirstlane(tid >> 6), lane = tid & 63, wr = wid >> 2, wc = wid & 3, fr = lane & 15, fq = lane >> 4;
    unsigned voffA[2], voffB[2]; const unsigned lda2 = (unsigned)g.lda * (unsigned)ES;
#pragma unroll
    for (int i = 0; i < 2; ++i) { int R, C; stage_rc(tid * 16 + i * 8192, R, C); const int Rb = Epi::PERM ? ((R & ~31) + perm32(R & 31)) : R;
        voffA[i] = GATHER ? (unsigned)C * 2u : (unsigned)(R * g.lda * ES + C * 2); voffB[i] = (unsigned)(Rb * g.ldb * ES + C * 2); }
    const size_t kstep = (size_t)(BK * 2);
    const size_t hstepA = (size_t)HALF * g.lda * ES, hstepB = (size_t)HALF * g.ldb * ES;
    const unsigned ldsw = (unsigned)wid * 1024u;
    const int aoff = lds_byte(wr * 64 + fr, fq * (ES == 2 ? 8 : 16)), boff = lds_byte(wc * 32 + fr, fq * (ES == 2 ? 8 : 16));
    constexpr int KFS = ES == 2 ? 1024 : 16;
#define PG8_SA(b, h) (((b) * 2 + (h)) * HTB)
#define PG8_SB(b, h) ((4 + (b) * 2 + (h)) * HTB)
#define PG8_STAGE2(bufoff, p0, p1) do { \
        __builtin_amdgcn_global_load_lds((const GAS unsigned*)(p0), (LAS unsigned*)(lds + (bufoff) + ldsw), 16, 0, 0); \
        __builtin_amdgcn_global_load_lds((const GAS unsigned*)(p1), (LAS unsigned*)(lds + (bufoff) + ldsw + 8192), 16, 0, 0); } while (0)
#define PG8_STAGE_B(b, h, base) PG8_STAGE2(PG8_SB(b, h), (base) + (h) * hstepB + voffB[0], (base) + (h) * hstepB + voffB[1])
#define PG8_STAGE_A(b, h, base, TK) PG8_STAGE2(PG8_SA(b, h), (base) + (GATHER ? (size_t)(((TK[0] >> (16 * (h))) & 0xffffu) * lda2 + voffA[0]) : (h) * hstepA + voffA[0]), (base) + (GATHER ? (size_t)(((TK[1] >> (16 * (h))) & 0xffffu) * lda2 + voffA[1]) : (h) * hstepA + voffA[1]))
#define PG8_LDA(dst, b, h) do { _Pragma("unroll") for (int m = 0; m < 4; ++m) _Pragma("unroll") for (int k = 0; k < 2; ++k) dst[m][k] = *(const LAS bf16x8*)(lds + PG8_SA(b, h) + aoff + m * 2048 + k * KFS); } while (0)
#define PG8_LDB(dst, b, h) do { _Pragma("unroll") for (int n = 0; n < 2; ++n) _Pragma("unroll") for (int k = 0; k < 2; ++k) dst[n][k] = *(const LAS bf16x8*)(lds + PG8_SB(b, h) + boff + n * 2048 + k * KFS); } while (0)
#define PG8_F8(x) __builtin_bit_cast(v8i32, (u32x4x2){__builtin_bit_cast(u32x4, x[0]), __builtin_bit_cast(u32x4, x[1])})
#define PG8_MMA(ai, bj, At, Bt) do { __builtin_amdgcn_s_setprio(1); _Pragma("unroll") for (int m = 0; m < 4; ++m) _Pragma("unroll") for (int n = 0; n < 2; ++n) { \
        if (ES == 2) { _Pragma("unroll") for (int k = 0; k < 2; ++k) acc[ai][bj][m][n] = __builtin_amdgcn_mfma_f32_16x16x32_bf16(Bt[n][k], At[m][k], acc[ai][bj][m][n], 0, 0, 0); } \
        else { const v8i32 b8_ = PG8_F8(Bt[n]), a8_ = PG8_F8(At[m]); asm volatile("v_mfma_f32_16x16x128_f8f6f4 %0, %1, %2, %0" : "+v"(acc[ai][bj][m][n]) : "v"(b8_), "v"(a8_)); } } \
        __builtin_amdgcn_s_setprio(0); } while (0)
#define PG8_WAIT_V(n) asm volatile("s_waitcnt vmcnt(" #n ")" ::: "memory")
#define PG8_WAIT_L(n) asm volatile("s_waitcnt lgkmcnt(" #n ")" ::: "memory")
#define PG8_BAR __builtin_amdgcn_s_barrier()
#define PG8_SCHED __builtin_amdgcn_sched_barrier(0)
#define PG8_KBODY(a1, a2, a3, b2, b3, AO1, AO2) do { \
        PG8_LDB(B0, 0, 0); PG8_SCHED; PG8_LDA(At, 0, 0); PG8_HOOK_RD; PG8_STAGE_A(1, 1, a1, AO1); \
        PG8_WAIT_L(8); PG8_BAR; PG8_WAIT_L(0); PG8_HOOK_SEL; PG8_MMA(0, 0, At, B0); PG8_BAR; PG8_SCHED; \
        PG8_LDB(B1, 0, 1); PG8_STAGE_B(0, 0, b2); \
        PG8_BAR; PG8_WAIT_L(0); PG8_MMA(0, 1, At, B1); PG8_BAR; \
        PG8_LDA(At, 0, 1); PG8_STAGE_A(0, 0, a2, AO2); \
        PG8_BAR; PG8_WAIT_L(0); PG8_MMA(1, 0, At, B0); PG8_BAR; PG8_SCHED; \
        PG8_STAGE_B(0, 1, b2); \
        PG8_WAIT_V(6); PG8_BAR; PG8_MMA(1, 1, At, B1); PG8_BAR; \
        PG8_LDB(B0, 1, 0); PG8_SCHED; PG8_LDA(At, 1, 0); PG8_STAGE_A(0, 1, a2, AO2); \
        PG8_WAIT_L(8); PG8_BAR; PG8_WAIT_L(0); PG8_MMA(0, 0, At, B0); PG8_BAR; PG8_SCHED; \
        PG8_LDB(B1, 1, 1); PG8_STAGE_B(1, 0, b3); \
        PG8_BAR; PG8_WAIT_L(0); PG8_MMA(0, 1, At, B1); PG8_BAR; \
        PG8_LDA(At, 1, 1); PG8_STAGE_A(1, 0, a3, AO2); \
        PG8_BAR; PG8_WAIT_L(0); PG8_MMA(1, 0, At, B0); PG8_BAR; PG8_SCHED; \
        PG8_STAGE_B(1, 1, b3); \
        PG8_WAIT_V(6); PG8_BAR; PG8_MMA(1, 1, At, B1); PG8_BAR; } while (0)
#define PG8_GOFF(TK, U) do { _Pragma("unroll") for (int i = 0; i < 2; ++i) { int R, C; stage_rc(tid * 16 + i * 8192, R, C); \
        const int q0_ = g.list[(U).a0 + R], q1_ = g.list[(U).a0 + HALF + R];        \
        const int t0 = (R < (U).cnt) ? q0_ : 0, t1 = (HALF + R < (U).cnt) ? q1_ : 0; TK[i] = (unsigned)t0 | ((unsigned)t1 << 16); } } while (0)
    Unit cur, nxt; int ui = 0;
    if (!S.next(0, cur)) return;
    f32x4 acc[2][2][4][2];
#pragma unroll
    for (int a = 0; a < 2; ++a)
#pragma unroll
        for (int b = 0; b < 2; ++b)
#pragma unroll
            for (int m = 0; m < 4; ++m)
#pragma unroll
                for (int n = 0; n < 2; ++n) acc[a][b][m][n] = zero4();
    bf16x8 At[4][2], B0[2][2], B1[2][2];
    unsigned aoC[2] = {0u, 0u};
    LAS unsigned* stash = (LAS unsigned*)(lds + STAGE_BYTES + 1024);
    if (GATHER) PG8_GOFF(aoC, cur);
    const GAS char* cA = (const GAS char*)g.A + (GATHER ? (size_t)cur.k0 * ES : ((size_t)cur.a0 * g.lda + cur.k0) * ES);
    const GAS char* cB = (const GAS char*)g.Bt + ((size_t)cur.b0 * g.ldb + cur.k0) * ES;
    PG8_STAGE_B(0, 0, cB); PG8_STAGE_A(0, 0, cA, aoC); PG8_STAGE_B(0, 1, cB); PG8_STAGE_A(0, 1, cA, aoC);
    if (wr == 1) PG8_BAR;
    PG8_WAIT_V(4); PG8_BAR;
    PG8_STAGE_B(1, 0, cB + kstep); PG8_STAGE_A(1, 0, cA + kstep, aoC); PG8_STAGE_B(1, 1, cB + kstep);
    PG8_WAIT_V(6); PG8_BAR;
    for (;;) {
        const bool has_next = S.next(ui + 1, nxt);
        unsigned aoN[2] = {0u, 0u};
        if (GATHER) { if (has_next) PG8_GOFF(aoN, nxt); else { aoN[0] = aoC[0]; aoN[1] = aoC[1]; } stash[tid] = aoN[0]; stash[512 + tid] = aoN[1]; }
        const GAS char* nA = has_next ? (const GAS char*)g.A + (GATHER ? (size_t)nxt.k0 * ES : ((size_t)nxt.a0 * g.lda + nxt.k0) * ES) : cA;
        const GAS char* nB = has_next ? (const GAS char*)g.Bt + ((size_t)nxt.b0 * g.ldb + nxt.k0) * ES : cB;
        const int nt = cur.nk;
        for (int t = 0; t < nt; t += 2) {
            const bool last = (t == nt - 2);
            const GAS char* a1 = cA + (size_t)(t + 1) * kstep;
            const GAS char* a2 = last ? nA : cA + (size_t)(t + 2) * kstep; const GAS char* b2 = last ? nB : cB + (size_t)(t + 2) * kstep;
            unsigned aoX[2] = {0u, 0u}, rN0 = 0u, rN1 = 0u;
#define PG8_HOOK_RD do { if (GATHER) { rN0 = stash[tid]; rN1 = stash[512 + tid]; } } while (0)
#define PG8_HOOK_SEL do { if (GATHER) { asm volatile("" : "+v"(rN0), "+v"(rN1)); aoX[0] = last ? rN0 : aoC[0]; aoX[1] = last ? rN1 : aoC[1]; } } while (0)
            PG8_KBODY(a1, a2, (a2 + kstep), b2, (b2 + kstep), aoC, aoX);
            if constexpr (Epi::MID) { if (t + 2 == Epi::MID_T) { PG8_SCHED; E.mid(acc, cur, wr, wc, fr, fq); PG8_SCHED; } }
#undef PG8_HOOK_RD
#undef PG8_HOOK_SEL
        }
        if (wr == 0) PG8_BAR;
        if (ES == 1) asm volatile("s_nop 15\n\ts_nop 15\n\ts_nop 15" ::: "memory");
        E(acc, cur, wr, wc, fr, fq);
        if (!has_next) break;
#pragma unroll
        for (int a = 0; a < 2; ++a)
#pragma unroll
            for (int b = 0; b < 2; ++b)
#pragma unroll
                for (int m = 0; m < 4; ++m)
#pragma unroll
                    for (int n = 0; n < 2; ++n) acc[a][b][m][n] = zero4();
        cur = nxt; cA = nA; cB = nB; ++ui;
        if (GATHER) { aoC[0] = stash[tid]; aoC[1] = stash[512 + tid]; }
        if (wr == 1) PG8_BAR;
    }
    PG8_WAIT_V(0);
    PG8_BAR;
#undef PG8_SA
#undef PG8_SB
#undef PG8_STAGE2
#undef PG8_STAGE_A
#undef PG8_STAGE_B
#undef PG8_LDA
#undef PG8_LDB
#undef PG8_MMA
#undef PG8_F8
#undef PG8_WAIT_V
#undef PG8_WAIT_L
#undef PG8_BAR
#undef PG8_SCHED
#undef PG8_KBODY
#undef PG8_GOFF
}
}

namespace pg8 {
struct EpiStoreBf16 {
    static constexpr bool MID = false;
    static constexpr bool PERM = true;
    GAS bf16* O; int ldc; float sc;
    __device__ __forceinline__ void operator()(const f32x4 (&acc)[2][2][4][2], const Unit& u, int wr, int wc, int fr, int fq) const {
        const int row0 = u.pm * BM + wr * 64 + fr, col0 = u.pn * BM + wc * 32 + 8 * fq;
#pragma unroll
        for (int ai = 0; ai < 2; ++ai)
#pragma unroll
            for (int m = 0; m < 4; ++m) { GAS bf16* rowp = O + (size_t)(row0 + ai * HALF + m * 16) * ldc + col0;
#pragma unroll
                for (int bj = 0; bj < 2; ++bj) { const f32x4 v0 = acc[ai][bj][m][0] * sc, v1 = acc[ai][bj][m][1] * sc;
                    u32x4 w; w.x = pk2(v0[0], v0[1]); w.y = pk2(v0[2], v0[3]); w.z = pk2(v1[0], v1[1]); w.w = pk2(v1[2], v1[3]);
                    *(GAS u32x4*)(rowp + bj * HALF) = w; } }
    }
};
struct EpiStoreFp8 {
    static constexpr bool MID = false;
    static constexpr bool PERM = true;
    GAS unsigned char* O; int ldc; float sc;
    __device__ __forceinline__ void operator()(const f32x4 (&acc)[2][2][4][2], const Unit& u, int wr, int wc, int fr, int fq) const {
        const int row0 = u.pm * BM + wr * 64 + fr, col0 = u.pn * BM + wc * 32 + 8 * fq;
#pragma unroll
        for (int ai = 0; ai < 2; ++ai)
#pragma unroll
            for (int m = 0; m < 4; ++m) { GAS unsigned char* rowp = O + (size_t)(row0 + ai * HALF + m * 16) * ldc + col0;
#pragma unroll
                for (int bj = 0; bj < 2; ++bj) { const f32x4 v0 = acc[ai][bj][m][0] * sc, v1 = acc[ai][bj][m][1] * sc;
                    u32x2 w; w.x = pk4_fp8(v0[0], v0[1], v0[2], v0[3]); w.y = pk4_fp8(v1[0], v1[1], v1[2], v1[3]);
                    *(GAS u32x2*)(rowp + bj * HALF) = w; } }
    }
};
struct EpiGateU8 {
    static constexpr bool MID = false;
    static constexpr bool PERM = true;
    GAS unsigned char* O; float sc;
    __device__ __forceinline__ void operator()(const f32x4 (&acc)[2][2][4][2], const Unit& u, int wr, int wc, int fr, int fq) const {
        const int row0 = u.pm * BM + wr * 64 + fr, col0 = u.pn * BM + wc * 32 + 8 * fq;
#pragma unroll
        for (int ai = 0; ai < 2; ++ai)
#pragma unroll
            for (int m = 0; m < 4; ++m) { GAS unsigned char* rowp = O + (size_t)(row0 + ai * HALF + m * 16) * (NINP * 2) + col0;
#pragma unroll
                for (int bj = 0; bj < 2; ++bj) { unsigned q[8];
#pragma unroll
                    for (int n = 0; n < 2; ++n)
#pragma unroll
                        for (int i = 0; i < 4; ++i) q[4 * n + i] = (unsigned)(sigmoidf_(acc[ai][bj][m][n][i] * sc) * 255.f + 0.5f);
                    u32x2 w; w.x = q[0] | (q[1] << 8) | (q[2] << 16) | (q[3] << 24); w.y = q[4] | (q[5] << 8) | (q[6] << 16) | (q[7] << 24);
                    *(GAS u32x2*)(rowp + bj * HALF) = w; } }
    }
};
struct EpiMerge {
    static constexpr bool MID = false;
    static constexpr bool PERM = true;
    GAS bf16* O; const GAS bf16* P;
    __device__ __forceinline__ void operator()(const f32x4 (&acc)[2][2][4][2], const Unit& u, int wr, int wc, int fr, int fq) const {
        const int row0 = u.pm * BM + wr * 64 + fr, col0 = u.pn * BM + wc * 32 + 8 * fq, seg = u.aux & 15; const bool hasprev = (u.aux & 16) != 0;
#pragma unroll
        for (int ai = 0; ai < 2; ++ai) {
            u32x2 gw[4][2]; u32x4 pw[4][2];
#pragma unroll
            for (int m = 0; m < 4; ++m)
#pragma unroll
                for (int bj = 0; bj < 2; ++bj) { const size_t row = (size_t)(row0 + ai * HALF + m * 16); const int col = col0 + bj * HALF;
                    gw[m][bj] = *(const GAS u32x2*)((const GAS unsigned char*)P + row * (NINP * 2) + 2 * PC_GATE + seg * 1024 + col);
                    pw[m][bj] = (u32x4){0u, 0u, 0u, 0u}; if (hasprev) pw[m][bj] = *(const GAS u32x4*)(O + row * 1024 + col); }
#pragma unroll
            for (int m = 0; m < 4; ++m)
#pragma unroll
                for (int bj = 0; bj < 2; ++bj) { const size_t row = (size_t)(row0 + ai * HALF + m * 16); const int col = col0 + bj * HALF;
                    const u32x2 g2 = gw[m][bj]; const u32x4 p4 = pw[m][bj]; const f32x4 v0 = acc[ai][bj][m][0] * (1.f / 255.f), v1 = acc[ai][bj][m][1] * (1.f / 255.f);
                    float o[8];
                    o[0] = bflo(p4.x) + (float)(g2.x & 0xffu) * v0[0]; o[1] = bfhi(p4.x) + (float)((g2.x >> 8) & 0xffu) * v0[1];
                    o[2] = bflo(p4.y) + (float)((g2.x >> 16) & 0xffu) * v0[2]; o[3] = bfhi(p4.y) + (float)(g2.x >> 24) * v0[3];
                    o[4] = bflo(p4.z) + (float)(g2.y & 0xffu) * v1[0]; o[5] = bfhi(p4.z) + (float)((g2.y >> 8) & 0xffu) * v1[1];
                    o[6] = bflo(p4.w) + (float)((g2.y >> 16) & 0xffu) * v1[2]; o[7] = bfhi(p4.w) + (float)(g2.y >> 24) * v1[3];
                    u32x4 w; w.x = pk2(o[0], o[1]); w.y = pk2(o[2], o[3]); w.z = pk2(o[4], o[5]); w.w = pk2(o[6], o[7]);
                    *(GAS u32x4*)(O + row * 1024 + col) = w; }
        }
    }
};
struct SchedMergeAB {
    int G, c;
    __device__ __forceinline__ bool next(int i, Unit& u) const {
        const long L = (long)i * G + c; if (L >= 256) return false;
        tile_of((int)L, 64, 4, u.pm, u.pn); u.a0 = u.pm * BM; u.b0 = u.pn * BM; u.k0 = 0; u.nk = 8; u.aux = 1 | 16; u.cnt = BM; return true;
    }
    __device__ __forceinline__ void ready(const Unit&, int) const {}
};
struct EpiMergeAB {
    static constexpr bool PERM = true;
    static constexpr bool MID = true; static constexpr int MID_T = 4;
    GAS bf16* O; const GAS bf16* P;
    static __device__ __forceinline__ float gq(unsigned w, int k) { return fmaxf((float)((w >> (8 * k)) & 0xffu), 0.5f); }
    __device__ __forceinline__ void mid(f32x4 (&acc)[2][2][4][2], const Unit& u, int wr, int wc, int fr, int fq) const {
        unsigned rowq = (unsigned)(u.pm * BM + wr * 64 + fr), colq = (unsigned)(2 * PC_GATE + u.pn * BM + wc * 32 + 8 * fq); asm volatile("" : "+v"(rowq), "+v"(colq));
        const GAS unsigned char* gp0 = (const GAS unsigned char*)P + (size_t)rowq * (NINP * 2) + colq;
        u32x2 ga[2][2], gb[2][2];
#define MAB_LOAD(buf, idx) do { const GAS unsigned char* gp = gp0 + (size_t)(((idx) >> 2) * HALF + ((idx) & 3) * 16) * (NINP * 2); \
            ga[buf][0] = *(const GAS u32x2*)gp; gb[buf][0] = *(const GAS u32x2*)(gp + 1024); ga[buf][1] = *(const GAS u32x2*)(gp + HALF); gb[buf][1] = *(const GAS u32x2*)(gp + HALF + 1024); } while (0)
        MAB_LOAD(0, 0);
#pragma unroll
        for (int idx = 0; idx < 8; ++idx) {
            if (idx + 1 < 8) MAB_LOAD((idx + 1) & 1, idx + 1);
            __builtin_amdgcn_sched_barrier(0);
#pragma unroll
            for (int bj = 0; bj < 2; ++bj) { const u32x2 a2 = ga[idx & 1][bj], b2 = gb[idx & 1][bj];
#pragma unroll
                for (int e = 0; e < 4; ++e) { acc[idx >> 2][bj][idx & 3][0][e] *= gq(a2.x, e) * __builtin_amdgcn_rcpf(gq(b2.x, e)); acc[idx >> 2][bj][idx & 3][1][e] *= gq(a2.y, e) * __builtin_amdgcn_rcpf(gq(b2.y, e)); } }
            __builtin_amdgcn_sched_barrier(0);
        }
#undef MAB_LOAD
    }
    __device__ __forceinline__ void operator()(const f32x4 (&acc)[2][2][4][2], const Unit& u, int wr, int wc, int fr, int fq) const {
        const int row0 = u.pm * BM + wr * 64 + fr, col0 = u.pn * BM + wc * 32 + 8 * fq;
#pragma unroll
        for (int ai = 0; ai < 2; ++ai) {
            u32x2 gw[4][2]; u32x4 pw[4][2];
#pragma unroll
            for (int m = 0; m < 4; ++m)
#pragma unroll
                for (int bj = 0; bj < 2; ++bj) { const size_t row = (size_t)(row0 + ai * HALF + m * 16); const int col = col0 + bj * HALF;
                    gw[m][bj] = *(const GAS u32x2*)((const GAS unsigned char*)P + row * (NINP * 2) + 2 * PC_GATE + 1024 + col);
                    pw[m][bj] = *(const GAS u32x4*)(O + row * 1024 + col); }
#pragma unroll
            for (int m = 0; m < 4; ++m)
#pragma unroll
                for (int bj = 0; bj < 2; ++bj) { const size_t row = (size_t)(row0 + ai * HALF + m * 16); const int col = col0 + bj * HALF;
                    const u32x2 g2 = gw[m][bj]; const u32x4 p4 = pw[m][bj]; const f32x4 v0 = acc[ai][bj][m][0] * (1.f / 255.f), v1 = acc[ai][bj][m][1] * (1.f / 255.f);
                    float o[8];
                    o[0] = bflo(p4.x) + gq(g2.x, 0) * v0[0]; o[1] = bfhi(p4.x) + gq(g2.x, 1) * v0[1]; o[2] = bflo(p4.y) + gq(g2.x, 2) * v0[2]; o[3] = bfhi(p4.y) + gq(g2.x, 3) * v0[3];
                    o[4] = bflo(p4.z) + gq(g2.y, 0) * v1[0]; o[5] = bfhi(p4.z) + gq(g2.y, 1) * v1[1]; o[6] = bflo(p4.w) + gq(g2.y, 2) * v1[2]; o[7] = bfhi(p4.w) + gq(g2.y, 3) * v1[3];
                    u32x4 w; w.x = pk2(o[0], o[1]); w.y = pk2(o[2], o[3]); w.z = pk2(o[4], o[5]); w.w = pk2(o[6], o[7]);
                    *(GAS u32x4*)(O + row * 1024 + col) = w; }
        }
    }
};
struct EpiRes {
    static constexpr bool MID = false;
    static constexpr bool PERM = true;
    const GAS float* xres32; const GAS bf16* xres16; GAS bf16* X1; const GAS float* gt;
    __device__ __forceinline__ void operator()(const f32x4 (&acc)[2][2][4][2], const Unit& u, int wr, int wc, int fr, int fq) const {
        const int row0 = u.pm * BM + wr * 64 + fr, col0 = u.pn * BM + wc * 32 + 8 * fq;
        const GAS float* gb = gt + (size_t)((u.pm * BM) / SEQ) * 6144 + col0;
        f32x4 gv[2][2];
#pragma unroll
        for (int bj = 0; bj < 2; ++bj)
#pragma unroll
            for (int n = 0; n < 2; ++n) gv[bj][n] = *(const GAS f32x4*)(gb + bj * HALF + 4 * n);
#pragma unroll
        for (int ai = 0; ai < 2; ++ai) {
            if (xres32) {
#pragma unroll
                for (int mh = 0; mh < 2; ++mh) {
                    f32x4 xr[2][2][2];
#pragma unroll
                    for (int m = 0; m < 2; ++m)
#pragma unroll
                        for (int bj = 0; bj < 2; ++bj) { const size_t off = (size_t)(row0 + ai * HALF + (2 * mh + m) * 16) * 1024 + col0 + bj * HALF;
                            xr[m][bj][0] = *(const GAS f32x4*)(xres32 + off); xr[m][bj][1] = *(const GAS f32x4*)(xres32 + off + 4); }
#pragma unroll
                    for (int m = 0; m < 2; ++m)
#pragma unroll
                        for (int bj = 0; bj < 2; ++bj) { const size_t off = (size_t)(row0 + ai * HALF + (2 * mh + m) * 16) * 1024 + col0 + bj * HALF;
                            const f32x4 o0 = xr[m][bj][0] + gv[bj][0] * acc[ai][bj][2 * mh + m][0], o1 = xr[m][bj][1] + gv[bj][1] * acc[ai][bj][2 * mh + m][1];
                            u32x4 w; w.x = pk2(o0[0], o0[1]); w.y = pk2(o0[2], o0[3]); w.z = pk2(o1[0], o1[1]); w.w = pk2(o1[2], o1[3]);
                            *(GAS u32x4*)(X1 + off) = w; } }
            } else {
                u32x4 xw[4][2];
#pragma unroll
                for (int m = 0; m < 4; ++m)
#pragma unroll
                    for (int bj = 0; bj < 2; ++bj) xw[m][bj] = *(const GAS u32x4*)(xres16 + (size_t)(row0 + ai * HALF + m * 16) * 1024 + col0 + bj * HALF);
#pragma unroll
                for (int m = 0; m < 4; ++m)
#pragma unroll
                    for (int bj = 0; bj < 2; ++bj) { const size_t off = (size_t)(row0 + ai * HALF + m * 16) * 1024 + col0 + bj * HALF; const u32x4 w4 = xw[m][bj];
                        const f32x4 x0 = {bflo(w4.x), bfhi(w4.x), bflo(w4.y), bfhi(w4.y)}, x1 = {bflo(w4.z), bfhi(w4.z), bflo(w4.w), bfhi(w4.w)};
                        const f32x4 o0 = x0 + gv[bj][0] * acc[ai][bj][m][0], o1 = x1 + gv[bj][1] * acc[ai][bj][m][1];
                        u32x4 w; w.x = pk2(o0[0], o0[1]); w.y = pk2(o0[2], o0[3]); w.z = pk2(o1[0], o1[1]); w.w = pk2(o1[2], o1[3]);
                        *(GAS u32x4*)(X1 + off) = w; }
            }
        }
    }
};
struct EpiAct {
    static constexpr bool MID = false;
    static constexpr bool PERM = true;
    GAS unsigned char* O; float sc;
    __device__ __forceinline__ void operator()(const f32x4 (&acc)[2][2][4][2], const Unit& u, int wr, int wc, int fr, int fq) const {
        const int row0 = u.pm * BM + wr * 64 + fr, col0 = u.pn * 128 + wc * 32 + 8 * fq;
#pragma unroll
        for (int ai = 0; ai < 2; ++ai)
#pragma unroll
            for (int m = 0; m < 4; ++m) { GAS unsigned char* rowp = O + (size_t)(row0 + ai * HALF + m * 16) * DEXP + col0;
                float o[8];
#pragma unroll
                for (int n = 0; n < 2; ++n)
#pragma unroll
                    for (int i = 0; i < 4; ++i) { const float gt = acc[ai][0][m][n][i] * sc, up = acc[ai][1][m][n][i] * sc; o[4 * n + i] = gt * sigmoidf_(gt) * up; }
                u32x2 w; w.x = pk4_fp8(o[0], o[1], o[2], o[3]); w.y = pk4_fp8(o[4], o[5], o[6], o[7]);
                *(GAS u32x2*)rowp = w; }
    }
};
}

constexpr int NWAVES = 8, NTHR = 512;
struct Args { const float* in[36]; float* out; unsigned char* ws; int ph_lo, ph_hi; };
struct Frame {
    LAS unsigned char* lds;
    int tid, lane, wave, G, bid;
    const float* const* in;
    GAS float* out;
    unsigned char* ws;
};
#define WSP(T, off) ((GAS T*)(opaque_p(F.ws) + (off)))
#define INP(k) ((const GAS float*)F.in[opaque_s(k)])

struct MapId { __device__ __forceinline__ int operator()(int n) const { return n; } };
struct MapWin { __device__ __forceinline__ int operator()(int n) const { return n < 2048 ? n : (n < 2056 ? PC_IB + (n - 2048) : (n < 2824 ? n - 8 : PC_GATE + (n - 2824))); } };
struct MapOff { int off; __device__ __forceinline__ int operator()(int n) const { return n + off; } };
struct MapEin { __device__ __forceinline__ int operator()(int n) const { const int half = n >> 9, j = n & 511; return 256 * (j >> 7) + 128 * half + (j & 127); } };
template <class Map, bool F8>
__device__ __forceinline__ void tr_item(const GAS float* W, int N, GAS bf16* WT, int ldk, int koff, LAS float* scr, int item, int lane, Map map, float f8scale, int f8row = 0, GAS unsigned char* WT8 = nullptr) {
    const int nblk = (N + 63) / 64, kb = item / nblk, nb = item - kb * nblk, k0 = 64 * kb, n0 = 64 * nb;
    const int l15 = lane & 15, l4 = lane >> 4;
    f32x4 v[16];
    const bool ok = (n0 + 4 * l15) < N;
#pragma unroll
    for (int i = 0; i < 16; ++i) v[i] = ok ? *(const GAS f32x4*)(W + (size_t)(k0 + 4 * i + l4) * N + n0 + 4 * l15) : (f32x4){0.f, 0.f, 0.f, 0.f};
#pragma unroll
    for (int i = 0; i < 16; ++i) { LAS float* d = scr + (4 * i + l4) * 65 + 4 * l15; d[0] = v[i][0]; d[1] = v[i][1]; d[2] = v[i][2]; d[3] = v[i][3]; }
    LDS_WAIT(); asm volatile("" ::: "memory");
    const int c = lane & 7;
#pragma unroll
    for (int j = 0; j < 8; ++j) { const int n = (lane >> 3) + 8 * j; const LAS float* s = scr + (8 * c) * 65 + n;
        const int drow = map(n0 + n);
        if (F8 && drow >= f8row) { u32x2 o; o.x = pk4_fp8(s[0 * 65] * f8scale, s[1 * 65] * f8scale, s[2 * 65] * f8scale, s[3 * 65] * f8scale); o.y = pk4_fp8(s[4 * 65] * f8scale, s[5 * 65] * f8scale, s[6 * 65] * f8scale, s[7 * 65] * f8scale);
            if (n0 + n < N) *(GAS u32x2*)((WT8 ? WT8 : (GAS unsigned char*)WT) + (size_t)(drow - f8row) * ldk + koff + k0 + 8 * c) = o; }
        else { u32x4 o; o.x = pk2(s[0 * 65], s[1 * 65]); o.y = pk2(s[2 * 65], s[3 * 65]); o.z = pk2(s[4 * 65], s[5 * 65]); o.w = pk2(s[6 * 65], s[7 * 65]);
            if (n0 + n < N) *(GAS u32x4*)(WT + (size_t)map(n0 + n) * ldk + koff + k0 + 8 * c) = o; } }
    LDS_WAIT(); asm volatile("" ::: "memory");
}
__device__ __forceinline__ void p0_prologue(Frame& F) {
    {
        LAS float* condT = (LAS float*)F.lds;
        LAS float* part = condT + 8192;
        const GAS float* c = INP(1);
        for (int i = F.tid; i < 8192; i += NTHR) { const int b = i >> 10, k = i & 1023; const float x = c[i]; condT[k * 8 + b] = x * sigmoidf_(x); }
        __syncthreads();
        GAS float* mod = WSP(float, WS_MOD);
        for (int it = F.bid; it < DEPTH * 96; it += F.G) {
            const int l = it / 96, n0 = (it - l * 96) * 64;
            const GAS float* w = INP(2) + (size_t)l * 1024 * 6144 + n0 + F.lane;
            float a[8] = {0.f, 0.f, 0.f, 0.f, 0.f, 0.f, 0.f, 0.f};
            const int kb = F.wave * 128;
#pragma unroll 8
            for (int k = 0; k < 128; ++k) { const float wv = w[(size_t)(kb + k) * 6144];
                const f32x4 c0 = *(const LAS f32x4*)(condT + (kb + k) * 8), c1 = *(const LAS f32x4*)(condT + (kb + k) * 8 + 4);
                a[0] += c0[0] * wv; a[1] += c0[1] * wv; a[2] += c0[2] * wv; a[3] += c0[3] * wv; a[4] += c1[0] * wv; a[5] += c1[1] * wv; a[6] += c1[2] * wv; a[7] += c1[3] * wv; }
#pragma unroll
            for (int b = 0; b < 8; ++b) part[(F.wave * 8 + b) * 64 + F.lane] = a[b];
            __syncthreads();
            { const int b = F.tid >> 6, col = F.tid & 63; float s = INP(3)[(size_t)l * 6144 + n0 + col];
#pragma unroll
              for (int w8 = 0; w8 < 8; ++w8) s += part[(w8 * 8 + b) * 64 + col];
              mod[((size_t)l * 8 + b) * 6144 + n0 + col] = s; }
            __syncthreads();
        }
    }
}
constexpr int CV_IN = 16 * 93, CV_BRA = 4 * 16, CV_BRC = 8 * 16, CV_OUT = 16 * 16, CV_EIN1 = 16 * 16, CV_EOUT1 = 8 * 16, CV_LORA = 4 + 4 + 8, CV_RT = 16 + 16;
constexpr int CV_LAYER = CV_IN + 2 * CV_BRA + CV_BRC + CV_OUT + NEXP * CV_EIN1 + NEXP * CV_EOUT1 + CV_LORA + CV_RT, CV_ITEMS = CV_LAYER + 24;
struct MapAny { int kind, off; __device__ __forceinline__ int operator()(int n) const { return kind == 0 ? n + off : (kind == 1 ? MapWin()(n) : MapEin()(n)); } };
__device__ __forceinline__ void convert_item(Frame& F, int l, int it, LAS float* scr) {
    if (it >= CV_LAYER) { const int q = (it - CV_LAYER) * 64 + F.lane; *(GAS u32x4*)(WSP(bf16, WS_WRT) + ((size_t)l * 48 + 36) * 1024 + q * 8) = (u32x4){0u, 0u, 0u, 0u}; return; }
    int r = it, inp, N, ldk, koff = 0, kind = 0, moff = 0; float f8 = 0.f; size_t so, wo, wsb;
    if (r < CV_IN) {
        tr_item<MapAny, true>((const GAS float*)F.in[6] + (size_t)l * 1024 * NIN, NIN, WSP(bf16, WS_WTIN) + (size_t)l * NINP * 1024, 1024, 0, scr, r, F.lane, MapAny{1, 0}, F8S_WIN, PC_GATE, WSP(unsigned char, WS_WTIN8) + (size_t)l * 3072 * 1024); return; }
    if (false) { inp = 6; so = 0; N = NIN; wsb = WS_WTIN; wo = 0; ldk = 1024; kind = 1; }
    else if ((r -= CV_IN) < CV_BRA) { inp = 26; so = (size_t)l * 256 * 1024; N = 1024; wsb = WS_WTBR; wo = (size_t)l * 1024 * 1024; ldk = 1024; }
    else if ((r -= CV_BRA) < CV_BRA) { inp = 27; so = (size_t)l * 256 * 1024; N = 1024; wsb = WS_WTBR; wo = (size_t)l * 1024 * 1024; ldk = 1024; koff = 256; }
    else if ((r -= CV_BRA) < CV_BRC) { inp = 28; so = (size_t)l * 512 * 1024; N = 1024; wsb = WS_WTBR; wo = (size_t)l * 1024 * 1024; ldk = 1024; koff = 512; }
    else if ((r -= CV_BRC) < CV_OUT) { inp = 29; so = (size_t)l * 1024 * 1024; N = 1024; wsb = WS_WTOUT; wo = (size_t)l * 1024 * 1024; ldk = 1024; }
    else if ((r -= CV_OUT) < NEXP * CV_EIN1) { const int e = r / CV_EIN1; r -= e * CV_EIN1; inp = 34; so = ((size_t)l * NEXP + e) * 1024 * 1024; N = 1024; wsb = WS_WTEIN; wo = ((size_t)l * NEXP + e) * 1024 * 1024; ldk = 1024; kind = 2; f8 = F8S_EIN; }
    else if ((r -= NEXP * CV_EIN1) < NEXP * CV_EOUT1) { const int e = r / CV_EOUT1; r -= e * CV_EOUT1; inp = 35; so = ((size_t)l * NEXP + e) * 512 * 1024; N = 1024; wsb = WS_WTEOUT; wo = ((size_t)l * NEXP + e) * 1024 * 512; ldk = 512; f8 = F8S_EOUT; }
    else if ((r -= NEXP * CV_EOUT1) < 4) { inp = 9; so = (size_t)l * 64 * 256; N = 256; wsb = WS_LORA; wo = (size_t)l * 65536; ldk = 64; }
    else if ((r -= 4) < 4) { inp = 11; so = (size_t)l * 64 * 256; N = 256; wsb = WS_LORA; wo = (size_t)l * 65536 + 256 * 64; ldk = 64; }
    else if ((r -= 4) < 8) { inp = 12; so = (size_t)l * 128 * 256; N = 256; wsb = WS_LORA; wo = (size_t)l * 65536 + 2 * 256 * 64; ldk = 128; }
    else if ((r -= 8) < 16) { inp = 30; so = (size_t)l * 1024 * 4; N = 4; wsb = WS_WRT; wo = (size_t)l * 48 * 1024; ldk = 1024; }
    else { r -= 16; inp = 32; so = (size_t)l * 1024 * 32; N = 32; wsb = WS_WRT; wo = (size_t)l * 48 * 1024; ldk = 1024; moff = 4; }
    if (f8 != 0.f) tr_item<MapAny, true>((const GAS float*)F.in[inp] + so, N, (GAS bf16*)(opaque_p(F.ws) + wsb + wo), ldk, koff, scr, r, F.lane, MapAny{kind, moff}, f8);
    else tr_item<MapAny, false>((const GAS float*)F.in[inp] + so, N, (GAS bf16*)(opaque_p(F.ws) + wsb) + wo, ldk, koff, scr, r, F.lane, MapAny{kind, moff}, 1.f);
}
struct CvP { const GAS float* W; GAS bf16* WTb; GAS unsigned char* WT8b; int N, ldk, koff, r, kind, moff, f8row, mode, l; float f8; };
__device__ __forceinline__ CvP convert_params(Frame& F, int l, int it, bool valid) {
    CvP p; p.W = (const GAS float*)F.in[6]; p.WTb = nullptr; p.WT8b = nullptr; p.N = 64; p.ldk = 64; p.koff = 0; p.r = 0; p.kind = 0; p.moff = 0; p.f8row = 0; p.mode = 0; p.l = l; p.f8 = 0.f;
    if (!valid) return p;
    if (it >= CV_LAYER) { p.mode = 1; p.r = it - CV_LAYER; return p; }
    p.mode = 2;
    int r = it, inp, N, ldk, koff = 0, kind = 0, moff = 0; float f8 = 0.f; size_t so, wo, wsb;
    if (r < CV_IN) { p.W = (const GAS float*)F.in[6] + (size_t)l * 1024 * NIN; p.N = NIN; p.WTb = WSP(bf16, WS_WTIN) + (size_t)l * NINP * 1024; p.WT8b = WSP(unsigned char, WS_WTIN8) + (size_t)l * 3072 * 1024;
        p.ldk = 1024; p.r = r; p.kind = 1; p.f8 = F8S_WIN; p.f8row = PC_GATE; return p; }
    if ((r -= CV_IN) < CV_BRA) { inp = 26; so = (size_t)l * 256 * 1024; N = 1024; wsb = WS_WTBR; wo = (size_t)l * 1024 * 1024; ldk = 1024; }
    else if ((r -= CV_BRA) < CV_BRA) { inp = 27; so = (size_t)l * 256 * 1024; N = 1024; wsb = WS_WTBR; wo = (size_t)l * 1024 * 1024; ldk = 1024; koff = 256; }
    else if ((r -= CV_BRA) < CV_BRC) { inp = 28; so = (size_t)l * 512 * 1024; N = 1024; wsb = WS_WTBR; wo = (size_t)l * 1024 * 1024; ldk = 1024; koff = 512; }
    else if ((r -= CV_BRC) < CV_OUT) { inp = 29; so = (size_t)l * 1024 * 1024; N = 1024; wsb = WS_WTOUT; wo = (size_t)l * 1024 * 1024; ldk = 1024; }
    else if ((r -= CV_OUT) < NEXP * CV_EIN1) { const int e = r / CV_EIN1; r -= e * CV_EIN1; inp = 34; so = ((size_t)l * NEXP + e) * 1024 * 1024; N = 1024; wsb = WS_WTEIN; wo = ((size_t)l * NEXP + e) * 1024 * 1024; ldk = 1024; kind = 2; f8 = F8S_EIN; }
    else if ((r -= NEXP * CV_EIN1) < NEXP * CV_EOUT1) { const int e = r / CV_EOUT1; r -= e * CV_EOUT1; inp = 35; so = ((size_t)l * NEXP + e) * 512 * 1024; N = 1024; wsb = WS_WTEOUT; wo = ((size_t)l * NEXP + e) * 1024 * 512; ldk = 512; f8 = F8S_EOUT; }
    else if ((r -= NEXP * CV_EOUT1) < 4) { inp = 9; so = (size_t)l * 64 * 256; N = 256; wsb = WS_LORA; wo = (size_t)l * 65536; ldk = 64; }
    else if ((r -= 4) < 4) { inp = 11; so = (size_t)l * 64 * 256; N = 256; wsb = WS_LORA; wo = (size_t)l * 65536 + 256 * 64; ldk = 64; }
    else if ((r -= 4) < 8) { inp = 12; so = (size_t)l * 128 * 256; N = 256; wsb = WS_LORA; wo = (size_t)l * 65536 + 2 * 256 * 64; ldk = 128; }
    else if ((r -= 8) < 16) { inp = 30; so = (size_t)l * 1024 * 4; N = 4; wsb = WS_WRT; wo = (size_t)l * 48 * 1024; ldk = 1024; }
    else { r -= 16; inp = 32; so = (size_t)l * 1024 * 32; N = 32; wsb = WS_WRT; wo = (size_t)l * 48 * 1024; ldk = 1024; moff = 4; }
    p.W = (const GAS float*)F.in[inp] + so; p.N = N; p.ldk = ldk; p.koff = koff; p.r = r; p.kind = kind; p.moff = moff; p.f8 = f8;
    if (f8 != 0.f) p.WT8b = (GAS unsigned char*)(opaque_p(F.ws) + wsb + wo); else p.WTb = (GAS bf16*)(opaque_p(F.ws) + wsb) + wo;
    return p;
}
__device__ __forceinline__ void tr_load(const CvP& p, int lane, f32x4 (&v)[16]) {
    const int nblk = (p.N + 63) / 64, kb = p.r / nblk, nb = p.r - kb * nblk, k0 = 64 * kb, n0 = 64 * nb;
    const int l15 = lane & 15, l4 = lane >> 4;
    const bool ok = (n0 + 4 * l15) < p.N;
    const GAS float* wp = p.W + (size_t)(k0 + l4) * p.N + (ok ? n0 + 4 * l15 : 0);
#pragma unroll
    for (int i = 0; i < 16; ++i) v[i] = *(const GAS f32x4*)(wp + (size_t)(4 * i) * p.N);
}
__device__ __forceinline__ void tr_finish(Frame& F, const CvP& p, int lane, LAS float* scr, const f32x4 (&v)[16]) {
    if (p.mode == 1) { const int q = p.r * 64 + lane; *(GAS u32x4*)(WSP(bf16, WS_WRT) + ((size_t)p.l * 48 + 36) * 1024 + q * 8) = (u32x4){0u, 0u, 0u, 0u}; return; }
    if (p.mode != 2) return;
    const int nblk = (p.N + 63) / 64, kb = p.r / nblk, nb = p.r - kb * nblk, k0 = 64 * kb, n0 = 64 * nb;
    const int l15 = lane & 15, l4 = lane >> 4;
    const bool ok = (n0 + 4 * l15) < p.N;
#pragma unroll
    for (int i = 0; i < 16; ++i) { LAS float* d = scr + (4 * i + l4) * 65 + 4 * l15; const f32x4 x = v[i]; d[0] = ok ? x[0] : 0.f; d[1] = ok ? x[1] : 0.f; d[2] = ok ? x[2] : 0.f; d[3] = ok ? x[3] : 0.f; }
    LDS_WAIT(); asm volatile("" ::: "memory");
    const int c = lane & 7; const MapAny map{p.kind, p.moff};
#pragma unroll
    for (int j = 0; j < 8; ++j) { const int n = (lane >> 3) + 8 * j; const LAS float* s_ = scr + (8 * c) * 65 + n;
        const int drow = map(n0 + n);
        if (p.f8 != 0.f && drow >= p.f8row) { const float fs = p.f8; u32x2 o; o.x = pk4_fp8(s_[0 * 65] * fs, s_[1 * 65] * fs, s_[2 * 65] * fs, s_[3 * 65] * fs); o.y = pk4_fp8(s_[4 * 65] * fs, s_[5 * 65] * fs, s_[6 * 65] * fs, s_[7 * 65] * fs);
            if (n0 + n < p.N) *(GAS u32x2*)(p.WT8b + (size_t)(drow - p.f8row) * p.ldk + p.koff + k0 + 8 * c) = o; }
        else { u32x4 o; o.x = pk2(s_[0 * 65], s_[1 * 65]); o.y = pk2(s_[2 * 65], s_[3 * 65]); o.z = pk2(s_[4 * 65], s_[5 * 65]); o.w = pk2(s_[6 * 65], s_[7 * 65]);
            if (n0 + n < p.N) *(GAS u32x4*)(p.WTb + (size_t)drow * p.ldk + p.koff + k0 + 8 * c) = o; } }
    LDS_WAIT(); asm volatile("" ::: "memory");
}
__device__ __forceinline__ void cv_direct(Frame& F, const CvP& p, int lane) {
    if (p.mode == 1) { const int q = p.r * 64 + lane; *(GAS u32x4*)(WSP(bf16, WS_WRT) + ((size_t)p.l * 48 + 36) * 1024 + q * 8) = (u32x4){0u, 0u, 0u, 0u}; return; }
    if (p.mode != 2) return;
    const int nblk = (p.N + 63) / 64, kb = p.r / nblk, nb = p.r - kb * nblk, k0 = 64 * kb, n = 64 * nb + lane;
    const bool ok = n < p.N;
    const GAS float* wp = p.W + (size_t)k0 * p.N + (ok ? n : 0);
    float x[64];
#pragma unroll
    for (int k = 0; k < 64; ++k) x[k] = wp[(size_t)k * p.N];
    const MapAny map{p.kind, p.moff}; const int drow = map(n);
    if (p.f8 != 0.f && drow >= p.f8row) { const float fs = p.f8; GAS unsigned char* op = p.WT8b + (size_t)(drow - p.f8row) * p.ldk + p.koff + k0;
#pragma unroll
        for (int q = 0; q < 4; ++q) { u32x4 o; o.x = pk4_fp8(x[16 * q] * fs, x[16 * q + 1] * fs, x[16 * q + 2] * fs, x[16 * q + 3] * fs); o.y = pk4_fp8(x[16 * q + 4] * fs, x[16 * q + 5] * fs, x[16 * q + 6] * fs, x[16 * q + 7] * fs);
            o.z = pk4_fp8(x[16 * q + 8] * fs, x[16 * q + 9] * fs, x[16 * q + 10] * fs, x[16 * q + 11] * fs); o.w = pk4_fp8(x[16 * q + 12] * fs, x[16 * q + 13] * fs, x[16 * q + 14] * fs, x[16 * q + 15] * fs);
            if (ok) *(GAS u32x4*)(op + 16 * q) = o; } }
    else { GAS bf16* op = p.WTb + (size_t)drow * p.ldk + p.koff + k0;
#pragma unroll
        for (int q = 0; q < 8; ++q) { u32x4 o; o.x = pk2(x[8 * q], x[8 * q + 1]); o.y = pk2(x[8 * q + 2], x[8 * q + 3]); o.z = pk2(x[8 * q + 4], x[8 * q + 5]); o.w = pk2(x[8 * q + 6], x[8 * q + 7]);
            if (ok) *(GAS u32x4*)(op + 8 * q) = o; } }
}
constexpr int CV_EXP0 = CV_IN + 2 * CV_BRA + CV_BRC + CV_OUT, CV_EXP1 = CV_EXP0 + NEXP * CV_EIN1 + NEXP * CV_EOUT1;
__device__ __forceinline__ void convert_layer(Frame& F, int l, int vb, int nvb) {
    LAS float* scr = (LAS float*)(F.lds + F.wave * (64 * 65 * 4));
    for (int ix = vb * NWAVES + F.wave; ix < CV_ITEMS - (CV_EXP1 - CV_EXP0); ix += nvb * NWAVES) convert_item(F, l, ix < CV_EXP0 ? ix : ix + (CV_EXP1 - CV_EXP0), scr);
}
__device__ __forceinline__ void build_tp(Frame& F, int l, LAS int* tp) {
    if (F.tid < 32) tp[33 + F.tid] = (int)__hip_atomic_load(WSP(unsigned, WS_CTL) + CW_CNT + l * 32 + F.tid, __ATOMIC_RELAXED, __HIP_MEMORY_SCOPE_AGENT);
    __syncthreads();
    if (F.tid == 0) { int s = 0; for (int e = 0; e < 32; ++e) { tp[e] = s; s += (tp[33 + e] + 255) >> 8; } tp[32] = s; }
    __syncthreads();
    { LAS unsigned char* em = (LAS unsigned char*)(tp + 72); const int TT = tp[32];
      for (int rt = F.tid; rt < TT; rt += NTHR) { int e = 0;
#pragma unroll
          for (int j = 1; j < 32; ++j) e = (tp[j] <= rt) ? j : e;
          em[rt] = (unsigned char)e; } }
    __syncthreads();
}

__device__ __forceinline__ void moe_combine_row(Frame& F, int row, const GAS bf16* x1row, const GAS float* gt2, const LAS int* tp, f32x4 (&v)[4]) {
    const GAS int* rt = WSP(int, WS_ROUTE) + (size_t)row * 8;
    const int e1 = rt[0], e2 = rt[1], p1 = rt[6], p2 = rt[7]; const float w1 = __int_as_float(rt[4]), w2 = __int_as_float(rt[5]);
    const GAS unsigned char* y1 = WSP(unsigned char, WS_YB) + ((size_t)tp[e1] * 256 + p1) * 1024, *y2 = WSP(unsigned char, WS_YB) + ((size_t)tp[e2] * 256 + p2) * 1024;
#pragma unroll
    for (int j = 0; j < 4; ++j) { const int col = 4 * F.lane + 256 * j;
        const u32x2 xw = *(const GAS u32x2*)(x1row + col); const f32x4 x = {bflo(xw.x), bfhi(xw.x), bflo(xw.y), bfhi(xw.y)}, g = *(const GAS f32x4*)(gt2 + col);
        const int a = *(const GAS int*)(y1 + col), b = *(const GAS int*)(y2 + col);
        const f32x2 a0 = __builtin_amdgcn_cvt_pk_f32_fp8(a, false), a1 = __builtin_amdgcn_cvt_pk_f32_fp8(a, true), b0 = __builtin_amdgcn_cvt_pk_f32_fp8(b, false), b1 = __builtin_amdgcn_cvt_pk_f32_fp8(b, true);
        f32x4 m; m[0] = w1 * a0[0] + w2 * b0[0]; m[1] = w1 * a0[1] + w2 * b0[1]; m[2] = w1 * a1[0] + w2 * b1[0]; m[3] = w1 * a1[1] + w2 * b1[1];
        v[j] = x + g * m; }
}
#ifndef MK_ONE_LAUNCH
#define MK_ONE_LAUNCH 1
#endif
constexpr int NR1 = 1;
__device__ __forceinline__ void phase_norm1(Frame& F, int l) {
    LAS int* tp = (LAS int*)(F.lds + 131072);
#if !MK_ONE_LAUNCH
    if (l > 0) build_tp(F, l - 1, tp);
#endif
    const int gw = F.bid * NWAVES + F.wave, NGW = F.G * NWAVES, rpw = NT / NGW;
    const GAS float* g1 = INP(4) + (size_t)l * 1024;
    for (int run = gw; run * rpw < NT; run += NGW) {
        const int r0 = run * rpw, b = r0 / SEQ;
        const GAS float* mb = WSP(float, WS_MOD) + ((size_t)l * 8 + b) * 6144;
        f32x4 gsc[4], shv[4], gt2[4];
#pragma unroll
        for (int j = 0; j < 4; ++j) { const int col = 4 * F.lane + 256 * j; const f32x4 g = *(const GAS f32x4*)(g1 + col), sc = *(const GAS f32x4*)(mb + 1024 + col);
            gsc[j] = g * (sc + 1.0f); shv[j] = *(const GAS f32x4*)(mb + col);
            gt2[j] = l > 0 ? *(const GAS f32x4*)(WSP(float, WS_MOD) + ((size_t)(l - 1) * 8 + b) * 6144 + 5 * 1024 + col) : zero4(); }
#pragma unroll 1
        for (int i = 0; i < rpw; i += NR1) {
            f32x4 v[NR1][4];
            if (l == 0) {
#pragma unroll
                for (int k = 0; k < NR1; ++k)
#pragma unroll
                    for (int j = 0; j < 4; ++j) v[k][j] = *(const GAS f32x4*)(INP(0) + (size_t)(r0 + i + k) * 1024 + 4 * F.lane + 256 * j);
            } else {
                int e1[NR1], e2[NR1], p1[NR1], p2[NR1]; float w1[NR1], w2[NR1];
#pragma unroll
                for (int k = 0; k < NR1; ++k) { const GAS int* rt = WSP(int, WS_ROUTE) + (size_t)(r0 + i + k) * 8; e1[k] = rt[0]; e2[k] = rt[1]; p1[k] = rt[6]; p2[k] = rt[7]; w1[k] = __int_as_float(rt[4]); w2[k] = __int_as_float(rt[5]); }
                u32x2 xw[NR1][4]; int ya[NR1][4], yb[NR1][4];
#pragma unroll
                for (int k = 0; k < NR1; ++k) { const GAS bf16* x1row = WSP(bf16, WS_X1) + (size_t)(r0 + i + k) * 1024;
                    const GAS unsigned char* y1 = WSP(unsigned char, WS_YB) + ((size_t)tp[e1[k]] * 256 + p1[k]) * 1024, *y2 = WSP(unsigned char, WS_YB) + ((size_t)tp[e2[k]] * 256 + p2[k]) * 1024;
#pragma unroll
                    for (int j = 0; j < 4; ++j) { const int col = 4 * F.lane + 256 * j; xw[k][j] = *(const GAS u32x2*)(x1row + col); ya[k][j] = *(const GAS int*)(y1 + col); yb[k][j] = *(const GAS int*)(y2 + col); } }
#pragma unroll
                for (int k = 0; k < NR1; ++k)
#pragma unroll
                    for (int j = 0; j < 4; ++j) { const int a = ya[k][j], bb = yb[k][j]; const u32x2 x_ = xw[k][j];
                        const f32x4 x = {bflo(x_.x), bfhi(x_.x), bflo(x_.y), bfhi(x_.y)};
                        const f32x2 a0 = __builtin_amdgcn_cvt_pk_f32_fp8(a, false), a1 = __builtin_amdgcn_cvt_pk_f32_fp8(a, true), b0 = __builtin_amdgcn_cvt_pk_f32_fp8(bb, false), b1 = __builtin_amdgcn_cvt_pk_f32_fp8(bb, true);
                        f32x4 m; m[0] = w1[k] * a0[0] + w2[k] * b0[0]; m[1] = w1[k] * a0[1] + w2[k] * b0[1]; m[2] = w1[k] * a1[0] + w2[k] * b1[0]; m[3] = w1[k] * a1[1] + w2[k] * b1[1];
                        v[k][j] = x + gt2[j] * m;
                        u32x2 xo; xo.x = pk2(v[k][j][0], v[k][j][1]); xo.y = pk2(v[k][j][2], v[k][j][3]); *(GAS u32x2*)(WSP(bf16, WS_XA) + (size_t)(r0 + i + k) * 1024 + 4 * F.lane + 256 * j) = xo; }
            }
#pragma unroll
            for (int k = 0; k < NR1; ++k) { float ss = 0.f;
#pragma unroll
                for (int j = 0; j < 4; ++j) ss += (v[k][j][0] * v[k][j][0] + v[k][j][1] * v[k][j][1]) + (v[k][j][2] * v[k][j][2] + v[k][j][3] * v[k][j][3]);
                const float rstd = rsqrtf(wave_sum(ss) * (1.f / 1024.f) + 1e-6f);
#pragma unroll
                for (int j = 0; j < 4; ++j) { const int col = 4 * F.lane + 256 * j; const f32x4 h = v[k][j] * rstd * gsc[j] + shv[j];
                    u32x2 o; o.x = pk2(h[0], h[1]); o.y = pk2(h[2], h[3]);
                    *(GAS u32x2*)(WSP(bf16, WS_H) + (size_t)(r0 + i + k) * 1024 + col) = o;
                    *(GAS unsigned*)(WSP(unsigned char, WS_H8) + (size_t)(r0 + i + k) * 1024 + col) = pk4_fp8(h[0], h[1], h[2], h[3]); } }
        }
    }
}
__device__ __forceinline__ void phase_final(Frame& F) {
    LAS int* tp = (LAS int*)(F.lds + 131072);
#if !MK_ONE_LAUNCH
    build_tp(F, DEPTH - 1, tp);
#endif
    const int gw = F.bid * NWAVES + F.wave, NGW = F.G * NWAVES;
    for (int row = gw; row < NT; row += NGW) {
        const int b = row / SEQ; f32x4 v[4];
        moe_combine_row(F, row, WSP(bf16, WS_X1) + (size_t)row * 1024, WSP(float, WS_MOD) + ((size_t)(DEPTH - 1) * 8 + b) * 6144 + 5 * 1024, tp, v);
#pragma unroll
        for (int j = 0; j < 4; ++j) *(GAS f32x4*)(F.out + (size_t)row * 1024 + 4 * F.lane + 256 * j) = v[j];
    }
}

__device__ __forceinline__ float tanhf_(float x) { return 1.0f - 2.0f * __builtin_amdgcn_rcpf(1.0f + __expf(2.0f * x)); }
__device__ __forceinline__ float logsigmoidf_(float x) { return fminf(x, 0.f) - __logf(1.0f + __expf(-fabsf(x))); }
__device__ __forceinline__ void phase_prep(Frame& F, int l) {
    const GAS bf16* P = WSP(bf16, WS_P);
    GAS float* RW = WSP(float, WS_RW);
    {
        LAS unsigned char* L = F.lds;
        GAS float* RWSl = WSP(float, WS_RWS) + (size_t)l * NT * 1280;
        const GAS float* mu = INP(7) + (size_t)l * 1024; const GAS float* w0 = INP(8) + (size_t)l * 256; const GAS float* a0 = INP(10) + (size_t)l * 256;
        const GAS float* kkp = INP(13) + (size_t)l * 256; const GAS float* kap = INP(14) + (size_t)l * 256; const GAS float* rkp = INP(15) + (size_t)l * 256;
        const GAS bf16* w2t = WSP(bf16, WS_LORA) + (size_t)l * 65536; const GAS bf16* a2t = w2t + 256 * 64; const GAS bf16* g2t = w2t + 2 * 256 * 64;
        const int l15 = F.lane & 15, g = F.lane >> 4, h = F.wave >> 1, th = F.wave & 1;
        LAS float* PAR = (LAS float*)(F.lds + 34816);
        { const float ma = mu[F.tid]; float pv[6] = {0.f, 0.f, 0.f, 0.f, 0.f, 0.f};
          if (F.tid < 256) { pv[0] = mu[512 + F.tid]; pv[1] = w0[F.tid]; pv[2] = a0[F.tid]; pv[3] = kkp[F.tid]; pv[4] = kap[F.tid]; pv[5] = rkp[F.tid]; }
          PAR[F.tid] = ma;
          if (F.tid < 256) { PAR[512 + F.tid] = pv[0]; PAR[768 + F.tid] = pv[1]; PAR[1024 + F.tid] = pv[2]; PAR[1280 + F.tid] = pv[3]; PAR[1536 + F.tid] = pv[4]; PAR[1792 + F.tid] = pv[5]; } }
        for (int tt = F.bid; tt < NT / 64; tt += F.G) {
            const int t0 = tt * 64;
            { const int tok = F.tid >> 3, ch = F.tid & 7, c0 = 768 + 32 * ch, row = t0 + tok; const bool first = (row % SEQ) == 0;
              const GAS bf16* pr = P + (size_t)row * NINP + c0; const GAS bf16* pp = pr - (first ? 0 : NINP);
              u32x4 cw[4], pw[4]; f32x4 m4[8];
#pragma unroll
              for (int q = 0; q < 4; ++q) { cw[q] = *(const GAS u32x4*)(pr + 8 * q); pw[q] = *(const GAS u32x4*)(pp + 8 * q); }
#pragma unroll
              for (int j = 0; j < 8; ++j) m4[j] = *(const GAS f32x4*)(mu + c0 + 4 * j);
              const float ka = ch < 2 ? 2.0f : 1.0f;
#pragma unroll
              for (int q = 0; q < 4; ++q) { u32x4 o;
#pragma unroll
                  for (int e = 0; e < 4; ++e) {
                      const float c_lo = bflo(cw[q][e]), c_hi = bfhi(cw[q][e]), p_lo = first ? 0.f : bflo(pw[q][e]), p_hi = first ? 0.f : bfhi(pw[q][e]);
                      const float mu0 = m4[2 * q + (e >> 1)][2 * (e & 1)], mu1 = m4[2 * q + (e >> 1)][2 * (e & 1) + 1];
                      float m0 = c_lo + mu0 * (p_lo - c_lo), m1 = c_hi + mu1 * (p_hi - c_hi);
                      const float s0 = sigmoidf_(ka * m0), s1 = sigmoidf_(ka * m1);
                      m0 = ch < 2 ? 2.0f * s0 - 1.0f : (ch >= 4 ? s0 : m0); m1 = ch < 2 ? 2.0f * s1 - 1.0f : (ch >= 4 ? s1 : m1);
                      o[e] = pk2(m0, m1); }
                  *(LAS u32x4*)(L + tok * 528 + (32 * ch + 8 * q) * 2) = o; } }
            __syncthreads();
#pragma unroll 1
            for (int tb = 0; tb < 2; ++tb) {
                const int row = t0 + 32 * th + 16 * tb + l15; const bool first = (row % SEQ) == 0;
                const GAS bf16* pr = P + (size_t)row * NINP; const GAS bf16* pp = pr - (first ? 0 : NINP);
                f32x4 dw[4], da[4], dg[4];
#pragma unroll
                for (int cb = 0; cb < 4; ++cb) { dw[cb] = (f32x4){0.f, 0.f, 0.f, 0.f}; da[cb] = dw[cb]; dg[cb] = dw[cb]; }
                bf16x8 Uf[8];
#pragma unroll
                for (int ks = 0; ks < 8; ++ks) Uf[ks] = *(const LAS bf16x8*)(L + (32 * th + 16 * tb + l15) * 528 + (32 * ks + 8 * g) * 2);
                bf16x8 Aw[2][2], Aa[2][2], Ag[2][4];
#define LA_LOAD(buf, cbx) do { const int c_ = 64 * h + 16 * (cbx) + l15; \
                    _Pragma("unroll") for (int ks = 0; ks < 2; ++ks) { Aw[buf][ks] = *(const GAS bf16x8*)(w2t + c_ * 64 + 32 * ks + 8 * g); Aa[buf][ks] = *(const GAS bf16x8*)(a2t + c_ * 64 + 32 * ks + 8 * g); } \
                    _Pragma("unroll") for (int ks = 0; ks < 4; ++ks) Ag[buf][ks] = *(const GAS bf16x8*)(g2t + c_ * 128 + 32 * ks + 8 * g); } while (0)
#pragma unroll
                for (int cb = 0; cb < 4; ++cb) {
                    LA_LOAD(0, cb);
                    __builtin_amdgcn_sched_barrier(0);
#pragma unroll
                    for (int ks = 0; ks < 2; ++ks) { dw[cb] = PG8_MFMA(Aw[0][ks], Uf[ks], dw[cb]); da[cb] = PG8_MFMA(Aa[0][ks], Uf[2 + ks], da[cb]); }
#pragma unroll
                    for (int ks = 0; ks < 4; ++ks) dg[cb] = PG8_MFMA(Ag[0][ks], Uf[4 + ks], dg[cb]);
                    __builtin_amdgcn_sched_barrier(0); }
#undef LA_LOAD
                u32x2 cwv[4][3], pwv[4][3];
#pragma unroll
                for (int cb = 0; cb < 4; ++cb)
#pragma unroll
                    for (int q = 0; q < 3; ++q) { const int col = 64 * h + 16 * cb + 4 * g; cwv[cb][q] = *(const GAS u32x2*)(pr + 256 * q + col); pwv[cb][q] = *(const GAS u32x2*)(pp + 256 * q + col); }
                {
                f32x4 kkv[4], av_[4], vv[4], rr[4], k2[4], gsv[4]; float ss = 0.f, rks = 0.f;
#pragma unroll
                for (int cb = 0; cb < 4; ++cb) { const int col = 64 * h + 16 * cb + 4 * g;
                    f32x4 mx3[3];
#pragma unroll
                    for (int q = 0; q < 3; ++q) { const u32x2 cw = cwv[cb][q], pw = keep2(!first, pwv[cb][q]);
                        const f32x4 m4 = *(const LAS f32x4*)(PAR + 256 * q + col);
                        const f32x4 cv = {bflo(cw.x), bfhi(cw.x), bflo(cw.y), bfhi(cw.y)}, pv = {bflo(pw.x), bfhi(pw.x), bflo(pw.y), bfhi(pw.y)};
                        mx3[q] = cv + m4 * (pv - cv); }
                    const f32x4 w04 = *(const LAS f32x4*)(PAR + 768 + col), a04 = *(const LAS f32x4*)(PAR + 1024 + col), kk4 = *(const LAS f32x4*)(PAR + 1280 + col), ka4 = *(const LAS f32x4*)(PAR + 1536 + col), rk4 = *(const LAS f32x4*)(PAR + 1792 + col);
                    f32x4 dec, aa;
#pragma unroll
                    for (int i = 0; i < 4; ++i) { dec[i] = __expf(-0.60653066f * sigmoidf_(dw[cb][i] + w04[i])); aa[i] = sigmoidf_(da[cb][i] + a04[i]); }
                    rr[cb] = mx3[0]; vv[cb] = mx3[2]; av_[cb] = aa; kkv[cb] = mx3[1] * kk4; k2[cb] = mx3[1] * ((aa - 1.0f) * ka4 + 1.0f);
                    const f32x4 t1 = kkv[cb] * kkv[cb], t2 = rr[cb] * k2[cb] * rk4;
                    ss += (t1[0] + t1[1]) + (t1[2] + t1[3]); rks += (t2[0] + t2[1]) + (t2[2] + t2[3]);
                    const size_t o = (size_t)row * 256 + col, os = (size_t)row * 1280 + h * 320 + 16 * cb + 4 * g;
                    *(GAS f32x4*)(RWSl + os + RW_W * 64) = dec; *(GAS f32x4*)(RWSl + os + RW_K * 64) = k2[cb]; *(GAS f32x4*)(RWSl + os + RW_R * 64) = rr[cb];
                    *(GAS f32x4*)(RW + RW_V * RW_STRIDE + o) = vv[cb]; gsv[cb] = dg[cb]; }
                ss += shx(ss, F.lane, 16); ss += shx(ss, F.lane, 32); rks += shx(rks, F.lane, 16); rks += shx(rks, F.lane, 32);
                const float kinv = 1.0f / fmaxf(sqrtf(ss), 1e-12f);
#pragma unroll
                for (int cb = 0; cb < 4; ++cb) { const size_t o = (size_t)row * 256 + 64 * h + 16 * cb + 4 * g, os = (size_t)row * 1280 + h * 320 + 16 * cb + 4 * g; const f32x4 kkn = kkv[cb] * kinv;
                    *(GAS f32x4*)(RWSl + os + RW_AV * 64) = -kkn; *(GAS f32x4*)(RWSl + os + RW_BV * 64) = kkn * av_[cb]; const f32x4 bo = vv[cb] * rks, gg = gsv[cb];
                    u32x4 pw; pw.x = pk2(bo[0], gg[0]); pw.y = pk2(bo[1], gg[1]); pw.z = pk2(bo[2], gg[2]); pw.w = pk2(bo[3], gg[3]);
                    *(GAS u32x4*)((GAS unsigned*)(RW + RW_G * RW_STRIDE) + o) = pw; } } }
            __syncthreads();
        }
    }
    {
        const GAS float* cw = INP(18) + (size_t)l * 4 * 512; const GAS float* cb = INP(19) + (size_t)l * 512;
        const GAS float* bi = INP(20) + (size_t)l * 4; const GAS float* bfp = INP(21) + (size_t)l * 4;
        GAS bf16* QKB = WSP(bf16, WS_QKB); GAS float* GT = WSP(float, WS_GATES);
        const int c8 = (F.tid & 63) * 8;
        f32x4 wv[4][2]; f32x4 cbv[2];
#pragma unroll
        for (int j = 0; j < 4; ++j) { wv[j][0] = *(const GAS f32x4*)(cw + j * 512 + c8); wv[j][1] = *(const GAS f32x4*)(cw + j * 512 + c8 + 4); }
        cbv[0] = *(const GAS f32x4*)(cb + c8); cbv[1] = *(const GAS f32x4*)(cb + c8 + 4);
        const float sc = c8 >= 256 ? 0.125f : 1.0f;
        const f32x4 bi4 = *(const GAS f32x4*)bi, bf4 = *(const GAS f32x4*)bfp;
        for (int run = F.bid * 8 + (F.tid >> 6); run < NT / 8; run += F.G * 8) {
            const int rbase = run * 8, tb0 = rbase % SEQ;
            u32x4 xr[11], gv[8];
#pragma unroll
            for (int i = 0; i < 11; ++i) xr[i] = *(const GAS u32x4*)(P + (size_t)((i < 3 && tb0 == 0) ? rbase : rbase - 3 + i) * NINP + PC_QB + c8);
#pragma unroll
            for (int rr = 0; rr < 8; ++rr) gv[rr] = *(const GAS u32x4*)(P + (size_t)(rbase + rr) * NINP + PC_IB);
            if (tb0 == 0) { xr[0] = (u32x4){0u, 0u, 0u, 0u}; xr[1] = xr[0]; xr[2] = xr[0]; }
#pragma unroll
            for (int rr = 0; rr < 8; ++rr) { const int row = rbase + rr;
                f32x4 a0 = cbv[0], a1 = cbv[1];
#pragma unroll
                for (int j = 0; j < 4; ++j) { const u32x4 xv = xr[rr + j];
                    const f32x4 x0 = {bflo(xv.x), bfhi(xv.x), bflo(xv.y), bfhi(xv.y)}, x1 = {bflo(xv.z), bfhi(xv.z), bflo(xv.w), bfhi(xv.w)};
                    a0 = wv[j][0] * x0 + a0; a1 = wv[j][1] * x1 + a1; }
                float acc[8] = {a0[0], a0[1], a0[2], a0[3], a1[0], a1[1], a1[2], a1[3]};
#pragma unroll
                for (int e = 0; e < 8; ++e) acc[e] = acc[e] * sigmoidf_(acc[e]) * sc;
                u32x4 o; o.x = pk2(acc[0], acc[1]); o.y = pk2(acc[2], acc[3]); o.z = pk2(acc[4], acc[5]); o.w = pk2(acc[6], acc[7]);
                *(GAS u32x4*)(QKB + (size_t)row * 512 + c8) = o;
                if ((F.tid & 63) == 0) { const u32x4 g4 = gv[rr];
                    f32x4 ig, lf;
                    ig[0] = bflo(g4.x) + bi4[0]; ig[1] = bfhi(g4.x) + bi4[1]; ig[2] = bflo(g4.y) + bi4[2]; ig[3] = bfhi(g4.y) + bi4[3];
                    lf[0] = logsigmoidf_(bflo(g4.z) + bf4[0]); lf[1] = logsigmoidf_(bfhi(g4.z) + bf4[1]); lf[2] = logsigmoidf_(bflo(g4.w) + bf4[2]); lf[3] = logsigmoidf_(bfhi(g4.w) + bf4[3]);
                    *(GAS f32x4*)(GT + (size_t)row * 8) = ig; *(GAS f32x4*)(GT + (size_t)row * 8 + 4) = lf; }
            }
        }
    }
}

#define CAS __attribute__((address_space(4)))
typedef float f32x16 __attribute__((ext_vector_type(16)));
__device__ __forceinline__ int fragpos(int j) { return ((j >> 4) * 2 + ((j >> 2) & 1)) * 8 + ((j >> 3) & 1) * 4 + (j & 3); }
constexpr int SC_CH = 64, SC_NCH = SEQ / SC_CH;
__device__ __forceinline__ void scan_local_block(Frame& F, int l, int grp) {
    const int k = F.wave & 3, lane = F.lane;
    const int b = grp / SC_NCH, c = grp % SC_NCH, h = k, bh = 4 * b + h;
    const size_t tok0 = (size_t)b * SEQ + c * SC_CH;
    LAS unsigned char* ring = F.lds + k * 20480;
    const GAS float* src = WSP(float, WS_RWS) + ((size_t)l * NT + tok0) * 1280 + h * 320;
    if (F.wave >= 4) {
        f32x4 ld[10];
        const int e0s = lane >> 4, e0q = lane & 15;
#define S1_FETCH(sub) do { const GAS float* sb_ = src + (size_t)(8 * (sub)) * 1280; \
            _Pragma("unroll") for (int i = 0; i < 8; ++i) ld[i] = *(const GAS f32x4*)(sb_ + i * 1280 + 4 * lane); \
            ld[8] = *(const GAS f32x4*)(sb_ + e0s * 1280 + 256 + 4 * e0q); ld[9] = *(const GAS f32x4*)(sb_ + (e0s + 4) * 1280 + 256 + 4 * e0q); } while (0)
#define S1_PUT(buf) do { LAS unsigned char* rb_ = ring + (buf) * 10240; \
            _Pragma("unroll") for (int i = 0; i < 8; ++i) *(LAS f32x4*)(rb_ + i * 1280 + lane * 16) = ld[i]; \
            *(LAS f32x4*)(rb_ + e0s * 1280 + 1024 + e0q * 16) = ld[8]; *(LAS f32x4*)(rb_ + (e0s + 4) * 1280 + 1024 + e0q * 16) = ld[9]; } while (0)
        S1_FETCH(0); S1_PUT(0);
        __syncthreads();
        LAS float* cscr = (LAS float*)(F.lds + 81920 + (F.wave - 4) * 16640);
        int cit = grp * 4 + (F.wave - 4);
#pragma unroll 1
        for (int sub = 0; sub < SC_CH / 8; ++sub) {
            if (sub + 1 < SC_CH / 8) S1_FETCH(sub + 1);
#pragma unroll 1
            for (int j = 0; j < 2; ++j) {
                const bool ex = cit >= CV_EXP0 && cit < CV_EXP1;
                int lnc = lane; asm volatile("" : "+v"(lnc));
                const CvP p_ = convert_params(F, ex ? l : l + 1, cit, cit < CV_ITEMS && (ex || l + 1 < DEPTH));
                cv_direct(F, p_, lnc);
                cit += 1024; }
            if (sub + 1 < SC_CH / 8) S1_PUT((sub + 1) & 1);
            __syncthreads();
        }
#undef S1_FETCH
#undef S1_PUT
        return;
    }
    f32x2 Xs[32], Ls[32];
    int ln = lane; asm volatile("" : "+v"(ln));
#pragma unroll
    for (int p = 0; p < 32; ++p) { Xs[p][0] = (ln == 2 * p) ? 1.f : 0.f; Xs[p][1] = (ln == 2 * p + 1) ? 1.f : 0.f; Ls[p] = (f32x2){0.f, 0.f}; }
    const GAS float* vp = WSP(float, WS_RW) + RW_V * RW_STRIDE + tok0 * 256 + 64 * h + lane;
    GAS bf16* YL = WSP(bf16, WS_YL) + (size_t)(bh * SC_NCH + c) * 4096 + (ln >> 5) * 1024 + (ln & 31) * 8;
    GAS bf16* ZB = WSP(bf16, WS_ZB) + (size_t)(bh * SC_NCH + c) * 4096 + (fragpos(ln) >> 3) * 256 + (fragpos(ln) & 7);
    float vcur = vp[0];
    __syncthreads();
#pragma unroll 1
    for (int sub = 0; sub < SC_CH / 8; ++sub) {
        const LAS unsigned char* sbuf = ring + (sub & 1) * 10240;
#pragma unroll 1
        for (int st = 0; st < 8; ++st) {
            const LAS unsigned char* q = sbuf + st * 1280;
            const int t = 8 * sub + st;
            const float vnext = (t + 1 < SC_CH) ? vp[(size_t)(t + 1) * 256] : 0.f;
#define S1_SB __builtin_amdgcn_sched_barrier(0)
            f32x2 d0 = {0.f, 0.f}, d1 = {0.f, 0.f}, e0 = {0.f, 0.f}, e1 = {0.f, 0.f};
            f32x4 aq[3][2];
#pragma unroll
            for (int g = 0; g < 2; ++g)
#pragma unroll
                for (int i = 0; i < 2; ++i) aq[g][i] = *(const LAS f32x4*)(q + RW_AV * 256 + 16 * (2 * g + i));
            f32x4 wq[3], bq[3], rq[3], kq[3];
#pragma unroll
            for (int j = 0; j < 2; ++j) { wq[j] = *(const LAS f32x4*)(q + RW_W * 256 + 16 * j); bq[j] = *(const LAS f32x4*)(q + RW_BV * 256 + 16 * j); rq[j] = *(const LAS f32x4*)(q + RW_R * 256 + 16 * j); kq[j] = *(const LAS f32x4*)(q + RW_K * 256 + 16 * j); }
#pragma unroll
            for (int g4 = 0; g4 < 8; ++g4) {
                if (g4 + 2 < 8) {
#pragma unroll
                    for (int i = 0; i < 2; ++i) aq[(g4 + 2) % 3][i] = *(const LAS f32x4*)(q + RW_AV * 256 + 16 * (2 * (g4 + 2) + i)); }
                S1_SB;
#pragma unroll
                for (int i = 0; i < 2; ++i) { const int jq = 2 * g4 + i; const f32x4 a4 = aq[g4 % 3][i]; const f32x2 aL = {a4[0], a4[1]}, aH = {a4[2], a4[3]};
                    d0 = Xs[2 * jq] * aL + d0; d1 = Xs[2 * jq + 1] * aH + d1; e0 = Ls[2 * jq] * aL + e0; e1 = Ls[2 * jq + 1] * aH + e1; }
                S1_SB;
            }
            const float sax = (d0[0] + d0[1]) + (d1[0] + d1[1]), sal = (e0[0] + e0[1]) + (e1[0] + e1[1]);
            const f32x2 sx2 = {sax, sax}, sl2 = {sal, sal}, v2 = {vcur, vcur};
            f32x2 z0 = {0.f, 0.f}, z1 = {0.f, 0.f}, y0 = {0.f, 0.f}, y1 = {0.f, 0.f};
#pragma unroll
            for (int jq = 0; jq < 16; ++jq) {
                if (jq + 2 < 16) { const int jn = jq + 2; wq[jn % 3] = *(const LAS f32x4*)(q + RW_W * 256 + 16 * jn); bq[jn % 3] = *(const LAS f32x4*)(q + RW_BV * 256 + 16 * jn);
                    rq[jn % 3] = *(const LAS f32x4*)(q + RW_R * 256 + 16 * jn); kq[jn % 3] = *(const LAS f32x4*)(q + RW_K * 256 + 16 * jn); }
                S1_SB;
                { const f32x4 w4 = wq[jq % 3], b4 = bq[jq % 3], r4 = rq[jq % 3], k4 = kq[jq % 3];
                    const f32x2 wL = {w4[0], w4[1]}, wH = {w4[2], w4[3]}, bL = {b4[0], b4[1]}, bH = {b4[2], b4[3]}, rL = {r4[0], r4[1]}, rH = {r4[2], r4[3]}, kL = {k4[0], k4[1]}, kH = {k4[2], k4[3]};
                    const f32x2 xa = Xs[2 * jq] * wL + sx2 * bL, xb = Xs[2 * jq + 1] * wH + sx2 * bH;
                    const f32x2 la = v2 * kL + (Ls[2 * jq] * wL + sl2 * bL), lb = v2 * kH + (Ls[2 * jq + 1] * wH + sl2 * bH);
                    Xs[2 * jq] = xa; Xs[2 * jq + 1] = xb; Ls[2 * jq] = la; Ls[2 * jq + 1] = lb;
                    z0 = xa * rL + z0; z1 = xb * rH + z1; y0 = la * rL + y0; y1 = lb * rH + y1; }
                S1_SB;
            }
#undef S1_SB
            const float z = (z0[0] + z0[1]) + (z1[0] + z1[1]), y = (y0[0] + y0[1]) + (y1[0] + y1[1]);
            YL[(t >> 5) * 2048 + ((t >> 4) & 1) * 512 + ((t >> 2) & 1) * 256 + ((t >> 3) & 1) * 4 + (t & 3)] = (bf16)(pk2(y, 0.f) & 0xffffu); ZB[(t >> 5) * 2048 + (t & 31) * 8] = (bf16)(pk2(z, 0.f) & 0xffffu);
            vcur = vnext;
        }
        __syncthreads();
    }
    {
        const size_t ob = ((size_t)(bh * SC_NCH + c) * 64) * 64;
        int ln2 = lane; asm volatile("" : "+v"(ln2));
        GAS bf16* UT = WSP(bf16, WS_UT) + ob + (ln2 >> 5) * 2048 + (ln2 & 31) * 8; GAS bf16* PT = WSP(bf16, WS_PT) + ob + (fragpos(ln2) >> 3) * 256 + (fragpos(ln2) & 7);
#pragma unroll
        for (int g8 = 0; g8 < 8; ++g8) {
            const int rb = g8 >> 2, hf = (g8 >> 1) & 1, hq = g8 & 1, m0 = 8 * rb + 4 * hf + hq;
            u32x4 w; w.x = pk2(Ls[2 * m0][0], Ls[2 * m0][1]); w.y = pk2(Ls[2 * m0 + 1][0], Ls[2 * m0 + 1][1]); w.z = pk2(Ls[2 * m0 + 4][0], Ls[2 * m0 + 4][1]); w.w = pk2(Ls[2 * m0 + 5][0], Ls[2 * m0 + 5][1]);
            *(GAS u32x4*)(UT + rb * 1024 + hf * 512 + hq * 256) = w; }
#pragma unroll
        for (int p = 0; p < 32; ++p) { const unsigned w = pk2(Xs[p][0], Xs[p][1]);
            PT[((2 * p) >> 5) * 2048 + ((2 * p) & 31) * 8] = (bf16)(w & 0xffffu); PT[((2 * p + 1) >> 5) * 2048 + ((2 * p + 1) & 31) * 8] = (bf16)(w >> 16); }
    }
}
constexpr int S2_RING = 4, S2_SPIN = 1 << 22;
__device__ __forceinline__ void s2_wait_ge(volatile LAS int* p, int need) { int it = 0; while (*p < need) { __builtin_amdgcn_s_sleep(1); if (++it > S2_SPIN) break; } asm volatile("" ::: "memory"); }
__device__ __forceinline__ void s2_publish(volatile LAS int* p, int v, int lane) { asm volatile("s_waitcnt lgkmcnt(0)" ::: "memory"); if (lane == 0) *p = v; asm volatile("" ::: "memory"); }
__device__ __forceinline__ void scan_combine_unit(Frame& F, int l, int bh) {
    const int b = bh >> 2, h = bh & 3, w = F.wave, lane = F.lane, r = lane & 31, hh = lane >> 5;
    LAS unsigned char* FR = F.lds;
    volatile LAS int* PRG = (volatile LAS int*)(F.lds + 32768);
    LAS float* ST = (LAS float*)(F.lds + 33024);
    if (F.tid < 16) PRG[F.tid] = 0;
    __syncthreads();
#define RQU(q) (((q) & 3) + 8 * ((q) >> 2))
    if (w < 2) {
        const int cb = w;
        const GAS bf16* UTg = WSP(bf16, WS_UT); const GAS bf16* PTg = WSP(bf16, WS_PT);
        int lz = lane; asm volatile("" : "+v"(lz));
        const unsigned lo_pt = lz * 8, lo_ut = cb * 2048 + lz * 8;
        f32x16 X0, X1;
#pragma unroll
        for (int q = 0; q < 16; ++q) { X0[q] = 0.f; X1[q] = 0.f; }
        f32x16 aU0, aU1, bU0, bU1; bf16x8 aP[2][4], bP[2][4];
#define S2_LOAD_S(U0_, U1_, P_, c_) do { const size_t pb = (size_t)(bh * SC_NCH + (c_)) * 4096; \
        _Pragma("unroll") for (int hf = 0; hf < 2; ++hf) { const u32x4 t0 = *(const GAS u32x4*)((UTg + pb + hf * 512) + lo_ut), t1 = *(const GAS u32x4*)((UTg + pb + 1024 + hf * 512) + lo_ut); \
            U0_[8 * hf] = bflo(t0.x); U0_[8 * hf + 1] = bfhi(t0.x); U0_[8 * hf + 2] = bflo(t0.y); U0_[8 * hf + 3] = bfhi(t0.y); U0_[8 * hf + 4] = bflo(t0.z); U0_[8 * hf + 5] = bfhi(t0.z); U0_[8 * hf + 6] = bflo(t0.w); U0_[8 * hf + 7] = bfhi(t0.w); \
            U1_[8 * hf] = bflo(t1.x); U1_[8 * hf + 1] = bfhi(t1.x); U1_[8 * hf + 2] = bflo(t1.y); U1_[8 * hf + 3] = bfhi(t1.y); U1_[8 * hf + 4] = bflo(t1.z); U1_[8 * hf + 5] = bfhi(t1.z); U1_[8 * hf + 6] = bflo(t1.w); U1_[8 * hf + 7] = bfhi(t1.w); } \
        _Pragma("unroll") for (int s4 = 0; s4 < 4; ++s4) { P_[0][s4] = *(const GAS bf16x8*)((PTg + pb + s4 * 512) + lo_pt); P_[1][s4] = *(const GAS bf16x8*)((PTg + pb + 2048 + s4 * 512) + lo_pt); } } while (0)
#define S2_TRIP_S(c, U0_, U1_, P_) do { \
        u32x4 fg[4]; \
        _Pragma("unroll") for (int s2 = 0; s2 < 2; ++s2) { fg[s2].x = pk2(X0[8 * s2 + 0], X0[8 * s2 + 1]); fg[s2].y = pk2(X0[8 * s2 + 2], X0[8 * s2 + 3]); fg[s2].z = pk2(X0[8 * s2 + 4], X0[8 * s2 + 5]); fg[s2].w = pk2(X0[8 * s2 + 6], X0[8 * s2 + 7]); \
            fg[2 + s2].x = pk2(X1[8 * s2 + 0], X1[8 * s2 + 1]); fg[2 + s2].y = pk2(X1[8 * s2 + 2], X1[8 * s2 + 3]); fg[2 + s2].z = pk2(X1[8 * s2 + 4], X1[8 * s2 + 5]); fg[2 + s2].w = pk2(X1[8 * s2 + 6], X1[8 * s2 + 7]); } \
        if ((c) >= S2_RING) { const int m0 = 2 * ((c) - S2_RING); s2_wait_ge(PRG + 2 + 2 * (m0 % 3) + cb, m0 + 1); s2_wait_ge(PRG + 2 + 2 * ((m0 + 1) % 3) + cb, m0 + 2); }        \
        { LAS unsigned char* sl = FR + (cb * S2_RING + ((c) & (S2_RING - 1))) * 4096 + lane * 16; \
          _Pragma("unroll") for (int s4 = 0; s4 < 4; ++s4) *(LAS u32x4*)(sl + s4 * 1024) = fg[s4]; } \
        s2_publish(PRG + cb, (c) + 1, lane); \
        X0 = U0_; X1 = U1_; \
        _Pragma("unroll") for (int s4 = 0; s4 < 4; ++s4) { const bf16x8 Bf = __builtin_bit_cast(bf16x8, fg[s4]); \
            X0 = __builtin_amdgcn_mfma_f32_32x32x16_bf16(P_[0][s4], Bf, X0, 0, 0, 0); X1 = __builtin_amdgcn_mfma_f32_32x32x16_bf16(P_[1][s4], Bf, X1, 0, 0, 0); } \
        S2_LOAD_S(U0_, U1_, P_, ((c) + 2 < SC_NCH ? (c) + 2 : SC_NCH - 1)); } while (0)
        S2_LOAD_S(aU0, aU1, aP, 0); S2_LOAD_S(bU0, bU1, bP, 1);
#pragma unroll 1
        for (int c2 = 0; c2 < SC_NCH; c2 += 2) { S2_TRIP_S(c2, aU0, aU1, aP); S2_TRIP_S(c2 + 1, bU0, bU1, bP); }
#undef S2_TRIP_S
#undef S2_LOAD_S
    } else {
        const int ow = w - 2, pair = ow >> 1, cb = ow & 1;
        LAS float* TT = (LAS float*)(F.lds + 57600) + ow * 1152;
        LAS bf16* OT = (LAS bf16*)(F.lds + 85248) + ow * 1280;
        LAS float* MR = (LAS float*)(F.lds + 100608) + ow * 64;
        const GAS bf16* ZBg = WSP(bf16, WS_ZB); const GAS bf16* YLg = WSP(bf16, WS_YL);
        const GAS unsigned* BG = (const GAS unsigned*)(WSP(float, WS_RW) + RW_G * RW_STRIDE); GAS bf16* YC = WSP(bf16, WS_YCAT);
        GAS bf16* DUMY = (GAS bf16*)(WSP(float, WS_RW) + RW_Y * RW_STRIDE) + (size_t)(bh * 6 + ow) * 32768;
        const int icol = 64 * h + 32 * cb + r;
        const float lgv = INP(16)[(size_t)l * 256 + icol], lbv = INP(17)[(size_t)l * 256 + icol];
        int lz = lane; asm volatile("" : "+v"(lz));
        const unsigned lo_z = lz * 8, lo_tok = 4 * (lz >> 5) * 256 + 64 * h + 32 * cb + (lz & 31), lo_yl = cb * 1024 + lz * 8, lo_yp = (lz & 31) * 1024 + 64 * h + 32 * cb + 16 * (lz >> 5);
        unsigned bv[16];
#pragma unroll
        for (int q = 0; q < 16; ++q) bv[q] = 0u;
        f32x16 aI, bI; bf16x8 aA[4], bA[4];
        constexpr int NTRIP = 22;
#define S2_LOAD_O(I_, A_, m_) do { const int mm = (m_) < 64 ? (m_) : 63; const size_t pb = (size_t)(bh * SC_NCH + (mm >> 1)) * 4096 + (mm & 1) * 2048; \
        _Pragma("unroll") for (int hf = 0; hf < 2; ++hf) { const u32x4 t4 = *(const GAS u32x4*)((YLg + pb + hf * 512) + lo_yl); \
            I_[8 * hf] = bflo(t4.x); I_[8 * hf + 1] = bfhi(t4.x); I_[8 * hf + 2] = bflo(t4.y); I_[8 * hf + 3] = bfhi(t4.y); I_[8 * hf + 4] = bflo(t4.z); I_[8 * hf + 5] = bfhi(t4.z); I_[8 * hf + 6] = bflo(t4.w); I_[8 * hf + 7] = bfhi(t4.w); } \
        _Pragma("unroll") for (int s4 = 0; s4 < 4; ++s4) A_[s4] = *(const GAS bf16x8*)((ZBg + pb + s4 * 512) + lo_z); } while (0)
#define S2_FINAL(mp, ip, real) do { const LAS float* sp_ = ST + ((ip) & 7) * 768 + pair * 256 + r * 2; const size_t tk = (size_t)b * SEQ + (mp) * 32; \
        { const f32x2 s0_ = *(const LAS f32x2*)(sp_), s1_ = *(const LAS f32x2*)(sp_ + 64), s2_ = *(const LAS f32x2*)(sp_ + 128), s3_ = *(const LAS f32x2*)(sp_ + 192); \
          const float mu = ((s0_[0] + s1_[0]) + (s2_[0] + s3_[0])) * (1.f / 64.f), var = ((s0_[1] + s1_[1]) + (s2_[1] + s3_[1])) * (1.f / 64.f) - mu * mu; \
          *(LAS f32x2*)(MR + r * 2) = (f32x2){mu, rsqrtf(fmaxf(var, 0.f) + 64e-5f)}; }        \
        asm volatile("s_waitcnt lgkmcnt(0)" ::: "memory"); \
        _Pragma("unroll") for (int q = 0; q < 16; ++q) { const int rq = RQU(q) + 4 * hh; const f32x2 mr_ = *(const LAS f32x2*)(MR + rq * 2); \
            const float yn = ((TT[rq * 36 + r] - mr_[0]) * mr_[1]) * lgv + lbv; \
            OT[rq * 40 + r] = (bf16)(pk2((yn + bflo(bv[q])) * bfhi(bv[q]), 0.f) & 0xffffu); } \
        asm volatile("s_waitcnt lgkmcnt(0)" ::: "memory"); \
        { const u32x4 o0 = *(const LAS u32x4*)(OT + r * 40 + 16 * hh), o1 = *(const LAS u32x4*)(OT + r * 40 + 16 * hh + 8); GAS bf16* yp = ((real) ? YC + tk * 1024 : DUMY) + lo_yp; \
          *(GAS u32x4*)yp = o0; *(GAS u32x4*)(yp + 8) = o1; } } while (0)
#define S2_TRIP_O(i, I_, A_) do { const int mr0 = pair + 3 * (i), m = mr0 < 64 ? mr0 : 63, c = m >> 1; \
        s2_wait_ge(PRG + cb, c + 1); \
        { const LAS unsigned char* sl = FR + (cb * S2_RING + (c & (S2_RING - 1))) * 4096 + lane * 16; \
          bf16x8 Bf[4]; _Pragma("unroll") for (int s4 = 0; s4 < 4; ++s4) Bf[s4] = *(const LAS bf16x8*)(sl + s4 * 1024); \
          _Pragma("unroll") for (int s4 = 0; s4 < 4; ++s4) I_ = __builtin_amdgcn_mfma_f32_32x32x16_bf16(A_[s4], Bf[s4], I_, 0, 0, 0); } \
        s2_publish(PRG + 2 + ow, m + 1, lane); \
        s2_wait_ge(PRG + 8 + (ow ^ 1), (i)); S2_FINAL(mr0 - 3, (i) - 1, (i) > 0); \
        { const size_t tk = (size_t)b * SEQ + m * 32; \
          _Pragma("unroll") for (int q = 0; q < 16; ++q) bv[q] = (BG + (tk + RQU(q)) * 256)[lo_tok]; } \
        _Pragma("unroll") for (int q = 0; q < 16; ++q) TT[(RQU(q) + 4 * hh) * 36 + r] = I_[q]; \
        S2_LOAD_O(I_, A_, mr0 + 6); \
        asm volatile("s_waitcnt lgkmcnt(0)" ::: "memory"); \
        { float s1 = 0.f, s2 = 0.f;        \
            _Pragma("unroll") for (int j = 0; j < 4; ++j) { const f32x4 t4 = *(const LAS f32x4*)(TT + r * 36 + 16 * hh + 4 * j); s1 += (t4[0] + t4[1]) + (t4[2] + t4[3]); s2 += (t4[0] * t4[0] + t4[1] * t4[1]) + (t4[2] * t4[2] + t4[3] * t4[3]); } \
            *(LAS f32x2*)(ST + ((i) & 7) * 768 + pair * 256 + cb * 128 + hh * 64 + r * 2) = (f32x2){s1, s2}; } \
        s2_publish(PRG + 8 + ow, (i) + 1, lane); } while (0)
        S2_LOAD_O(aI, aA, pair); S2_LOAD_O(bI, bA, pair + 3);
#pragma unroll 1
        for (int i2 = 0; i2 < NTRIP; i2 += 2) { S2_TRIP_O(i2, aI, aA); S2_TRIP_O(i2 + 1, bI, bA); }
        s2_wait_ge(PRG + 8 + (ow ^ 1), NTRIP); S2_FINAL(pair + 3 * (NTRIP - 1), NTRIP - 1, pair == 0);
#undef S2_TRIP_O
#undef S2_FINAL
#undef S2_LOAD_O
    }
#undef RQU
    __syncthreads();
}
constexpr int ML_QS = 0, ML_KS = 18432, ML_VT = 36864, ML_WKT = 54272, ML_CB = 88064, ML_NF = 97280, ML_FC = 97536, ML_IG = 98048, ML_GW = 98560, ML_PM = 99072, ML_TMP = 100352;
constexpr int MS_STRIDE = 4224;
__device__ __forceinline__ void mlstm_summary_unit(Frame& F, int l, int u) {
    const int bh = u >> 4, c = u & 15, b = bh >> 2, h = bh & 3;
    LAS unsigned char* L = F.lds;
    LAS float* Fc = (LAS float*)(L + ML_FC); LAS float* ig = (LAS float*)(L + ML_IG); LAS float* gw = (LAS float*)(L + ML_GW); LAS float* pm = (LAS float*)(L + ML_PM); LAS float* tmp = (LAS float*)(L + ML_TMP);
    const GAS bf16* P = WSP(bf16, WS_P); const GAS bf16* QKB = WSP(bf16, WS_QKB); const GAS float* GT = WSP(float, WS_GATES);
    GAS float* MS = WSP(float, WS_MSUM) + (size_t)u * MS_STRIDE;
    const int lane = F.lane, l15 = lane & 15, g = lane >> 4, w = F.wave;
    const size_t row0 = (size_t)b * SEQ + c * 128;
    u32x4 kxq[2][4], vvq[2];
    const int c8m = (F.tid & 7) * 8;
#pragma unroll
    for (int j = 0; j < 2; ++j) { const int r = (F.tid + NTHR * j) >> 3;
#pragma unroll
        for (int t = 0; t < 4; ++t) { const int pos = c * 128 + r - 3 + t; kxq[j][t] = *(const GAS u32x4*)(P + ((size_t)b * SEQ + (pos >= 0 ? pos : 0)) * NINP + PC_KB + 64 * h + c8m); }
        vvq[j] = *(const GAS u32x4*)(P + (row0 + r) * NINP + PC_VB + 64 * h + c8m); }
    f32x4 wvm[4][2], cbm[2];
    { const GAS float* cwp = INP(18) + (size_t)l * 4 * 512 + 256 + 64 * h + c8m; const GAS float* cbp = INP(19) + (size_t)l * 512 + 256 + 64 * h + c8m;
#pragma unroll
      for (int t = 0; t < 4; ++t) { wvm[t][0] = *(const GAS f32x4*)(cwp + t * 512); wvm[t][1] = *(const GAS f32x4*)(cwp + t * 512 + 4); }
      cbm[0] = *(const GAS f32x4*)cbp; cbm[1] = *(const GAS f32x4*)(cbp + 4); }
    const float bim = INP(20)[(size_t)l * 4 + h], bfm = INP(21)[(size_t)l * 4 + h];
    {
        float igv = 0.f, Fv = 0.f, pmv = -3.0e38f;
        if (F.tid < 128) { { const GAS unsigned short* pg = (const GAS unsigned short*)(P + (row0 + F.tid) * NINP + PC_IB + h); igv = bflo((unsigned)pg[0]) + bim; Fv = logsigmoidf_(bflo((unsigned)pg[4]) + bfm); }
#pragma unroll
            for (int o = 1; o < 64; o <<= 1) { const float n = shup(Fv, F.lane, o); if (lane >= o) Fv += n; }
            if (F.tid == 63) tmp[0] = Fv; }
        __syncthreads();
        if (F.tid < 128) { if (F.tid >= 64) Fv += tmp[0];
            pmv = igv - Fv;
#pragma unroll
            for (int o = 1; o < 64; o <<= 1) { const float n = shup(pmv, F.lane, o); if (lane >= o) pmv = fmaxf(pmv, n); }
            if (F.tid == 63) tmp[1] = pmv;
            ig[F.tid] = igv; Fc[F.tid] = Fv; }
        __syncthreads();
        if (F.tid >= 64 && F.tid < 128) pmv = fmaxf(pmv, tmp[1]);
        if (F.tid < 128) pm[F.tid] = pmv;
        __syncthreads();
        const float fl = Fc[127], m_loc = fl + pm[127];
        if (F.tid < 128) gw[F.tid] = __expf(fl - Fv + igv - m_loc);
        __syncthreads();
#pragma unroll
        for (int j = 0; j < 2; ++j) { const int it = F.tid + NTHR * j, r = it >> 3, c8 = (it & 7) * 8;
            f32x4 a0 = cbm[0], a1 = cbm[1];
#pragma unroll
            for (int t = 0; t < 4; ++t) { const u32x4 xv = keep4(c * 128 + r - 3 + t >= 0, kxq[j][t]);
                const f32x4 x0 = {bflo(xv.x), bfhi(xv.x), bflo(xv.y), bfhi(xv.y)}, x1 = {bflo(xv.z), bfhi(xv.z), bflo(xv.w), bfhi(xv.w)};
                a0 = wvm[t][0] * x0 + a0; a1 = wvm[t][1] * x1 + a1; }
            float ak[8] = {a0[0], a0[1], a0[2], a0[3], a1[0], a1[1], a1[2], a1[3]};
#pragma unroll
            for (int e = 0; e < 8; ++e) ak[e] = ak[e] * sigmoidf_(ak[e]) * 0.125f;
            u32x4 kv; kv.x = pk2(ak[0], ak[1]); kv.y = pk2(ak[2], ak[3]); kv.z = pk2(ak[4], ak[5]); kv.w = pk2(ak[6], ak[7]);
            const u32x4 vv = vvq[j];
            const float gs = gw[r];
#pragma unroll
            for (int e = 0; e < 4; ++e) { const unsigned kw = kv[e], vw = vv[e];
                const unsigned wk = pk2(bflo(kw) * gs, bfhi(kw) * gs);
                *(LAS bf16*)(L + ML_WKT + (c8 + 2 * e) * 272 + r * 2) = (bf16)(wk & 0xffffu); *(LAS bf16*)(L + ML_WKT + (c8 + 2 * e + 1) * 272 + r * 2) = (bf16)(wk >> 16);
                *(LAS bf16*)(L + ML_VT + (c8 + 2 * e) * 272 + r * 2) = (bf16)(vw & 0xffffu); *(LAS bf16*)(L + ML_VT + (c8 + 2 * e + 1) * 272 + r * 2) = (bf16)(vw >> 16); } }
        __syncthreads();
        f32x4 CL[2];
        { const int db = w & 3;
#pragma unroll
          for (int q = 0; q < 2; ++q) { const int eb = 2 * (w >> 2) + q; CL[q] = (f32x4){0.f, 0.f, 0.f, 0.f};
#pragma unroll
              for (int ks = 0; ks < 4; ++ks) { const bf16x8 Af = *(const LAS bf16x8*)(L + ML_VT + (16 * db + l15) * 272 + (8 * g + 32 * ks) * 2);
                  const bf16x8 Bf = *(const LAS bf16x8*)(L + ML_WKT + (16 * eb + l15) * 272 + (8 * g + 32 * ks) * 2); CL[q] = PG8_MFMA(Af, Bf, CL[q]); } } }
        float nloc = 0.f;
        if (F.tid < 64) {
#pragma unroll 4
            for (int q = 0; q < 16; ++q) { const u32x4 ww = *(const LAS u32x4*)(L + ML_WKT + F.tid * 272 + q * 16);
                nloc += (bflo(ww.x) + bfhi(ww.x)) + (bflo(ww.y) + bfhi(ww.y)) + (bflo(ww.z) + bfhi(ww.z)) + (bflo(ww.w) + bfhi(ww.w)); } }
        { const int db = w & 3;
#pragma unroll
          for (int q = 0; q < 2; ++q) { const int eb = 2 * (w >> 2) + q, e = 16 * eb + l15;
#pragma unroll
              for (int i = 0; i < 4; ++i) MS[(16 * db + 4 * g + i) * 64 + e] = CL[q][i]; }
          if (F.tid < 64) MS[4096 + F.tid] = nloc;
          if (F.tid == 0) { MS[4160] = m_loc; MS[4161] = fl; } }
        __syncthreads();
    }
}
__device__ __forceinline__ void mlstm_output_unit(Frame& F, int l, int u) {
    const int bh = u >> 4, c0_ = u & 15, c = u >= 448 ? ((c0_ + 8) & 15) : (u >= 224 ? 15 - c0_ : c0_), b = bh >> 2, h = bh & 3;
    LAS unsigned char* L = F.lds;
    LAS float* nf = (LAS float*)(L + ML_NF); LAS float* Fc = (LAS float*)(L + ML_FC); LAS float* ig = (LAS float*)(L + ML_IG); LAS float* pm = (LAS float*)(L + ML_PM); LAS float* tmp = (LAS float*)(L + ML_TMP);
    const GAS bf16* P = WSP(bf16, WS_P); const GAS bf16* QKB = WSP(bf16, WS_QKB); const GAS float* GT = WSP(float, WS_GATES); GAS bf16* YC = WSP(bf16, WS_YCAT);
    const GAS float* MS = WSP(float, WS_MSUM) + (size_t)bh * 16 * MS_STRIDE;
    const GAS float* hn = INP(22) + (size_t)l * 256 + 64 * h;
    const int lane = F.lane, l15 = lane & 15, g = lane >> 4, w = F.wave;
    const size_t row0 = (size_t)b * SEQ + c * 128;
    u32x4 qvq[2], kvq[2], vvq[2];
#pragma unroll
    for (int j = 0; j < 2; ++j) { const int it = F.tid + NTHR * j, r = it >> 3, c8 = (it & 7) * 8;
        qvq[j] = *(const GAS u32x4*)(QKB + (row0 + r) * 512 + 64 * h + c8); kvq[j] = *(const GAS u32x4*)(QKB + (row0 + r) * 512 + 256 + 64 * h + c8); vvq[j] = *(const GAS u32x4*)(P + (row0 + r) * NINP + PC_VB + 64 * h + c8); }
    {
        float igv = 0.f, Fv = 0.f, pmv = -3.0e38f;
        if (F.tid < 128) { igv = GT[(row0 + F.tid) * 8 + h]; Fv = GT[(row0 + F.tid) * 8 + 4 + h];
#pragma unroll
            for (int o = 1; o < 64; o <<= 1) { const float n = shup(Fv, F.lane, o); if (lane >= o) Fv += n; }
            if (F.tid == 63) tmp[0] = Fv; }
        __syncthreads();
        if (F.tid < 128) { if (F.tid >= 64) Fv += tmp[0];
            pmv = igv - Fv;
#pragma unroll
            for (int o = 1; o < 64; o <<= 1) { const float n = shup(pmv, F.lane, o); if (lane >= o) pmv = fmaxf(pmv, n); }
            if (F.tid == 63) tmp[1] = pmv;
            ig[F.tid] = igv; Fc[F.tid] = Fv; }
        __syncthreads();
        if (F.tid >= 64 && F.tid < 128) pmv = fmaxf(pmv, tmp[1]);
        if (F.tid < 128) pm[F.tid] = pmv;
        __syncthreads();
        f32x4 C0a = {0.f, 0.f, 0.f, 0.f}, C0b = C0a; float n0v = 0.f, m0 = 0.f;
        if (c > 0) {
            if (F.tid < c) { const f32x2 sc = *(const GAS f32x2*)(MS + (size_t)F.tid * MS_STRIDE + 4160); tmp[8 + F.tid] = sc[0]; tmp[24 + F.tid] = sc[1]; }
            __syncthreads();
            float G = 0.f, mfin = -3.0e38f;
            for (int cc = c - 1; cc >= 0; --cc) { mfin = fmaxf(mfin, tmp[8 + cc] + G); G += tmp[24 + cc]; }
            mfin = fmaxf(mfin, G); m0 = mfin;
            float Gs = 0.f;
#pragma unroll 1
            for (int c4 = c - 1; c4 >= 0; c4 -= 4) {
                f32x4 la[4], lb[4]; float ln[4];
#pragma unroll
                for (int q = 0; q < 4; ++q) { const int cc = c4 - q >= 0 ? c4 - q : 0; const GAS float* ms = MS + (size_t)cc * MS_STRIDE;
                    la[q] = *(const GAS f32x4*)(ms + 8 * F.tid); lb[q] = *(const GAS f32x4*)(ms + 8 * F.tid + 4); ln[q] = ms[4096 + (F.tid & 63)]; }
                __builtin_amdgcn_sched_barrier(0);
#pragma unroll
                for (int q = 0; q < 4; ++q) { const int cc = c4 - q; float wq = 0.f;
                    if (cc >= 0) { wq = __expf(tmp[8 + cc] + Gs - mfin); Gs += tmp[24 + cc]; }
                    C0a = la[q] * wq + C0a; C0b = lb[q] * wq + C0b; n0v = ln[q] * wq + n0v; }
            }
        }
#pragma unroll
        for (int j = 0; j < 2; ++j) { const int it = F.tid + NTHR * j, r = it >> 3, c8 = (it & 7) * 8;
            const u32x4 qv = qvq[j], kv = kvq[j], vv = vvq[j];
            *(LAS u32x4*)(L + ML_QS + r * 144 + c8 * 2) = qv; *(LAS u32x4*)(L + ML_KS + r * 144 + c8 * 2) = kv;
#pragma unroll
            for (int e = 0; e < 4; ++e) { const unsigned vw = vv[e];
                *(LAS bf16*)(L + ML_VT + (c8 + 2 * e) * 272 + r * 2) = (bf16)(vw & 0xffffu); *(LAS bf16*)(L + ML_VT + (c8 + 2 * e + 1) * 272 + r * 2) = (bf16)(vw >> 16); } }
        { const int d = F.tid >> 3, e8 = (F.tid & 7) * 8;
          u32x4 cw; cw.x = pk2(C0a[0], C0a[1]); cw.y = pk2(C0a[2], C0a[3]); cw.z = pk2(C0b[0], C0b[1]); cw.w = pk2(C0b[2], C0b[3]);
          *(LAS u32x4*)(L + ML_CB + d * 144 + e8 * 2) = cw; }
        if (F.tid < 64) nf[F.tid] = n0v;
        __syncthreads();
        {
            const int t = 16 * w + l15;
            bf16x8 Qf[2];
#pragma unroll
            for (int ks = 0; ks < 2; ++ks) Qf[ks] = *(const LAS bf16x8*)(L + ML_QS + t * 144 + (8 * g + 32 * ks) * 2);
            f32x4 st[8];
#pragma unroll
            for (int sb = 0; sb < 8; ++sb) { st[sb] = (f32x4){0.f, 0.f, 0.f, 0.f};
                if (sb <= w) {
#pragma unroll
                    for (int ks = 0; ks < 2; ++ks) { const bf16x8 Kf = *(const LAS bf16x8*)(L + ML_KS + (16 * sb + l15) * 144 + (8 * g + 32 * ks) * 2); st[sb] = PG8_MFMA(Kf, Qf[ks], st[sb]); } } }
            const float Ft = Fc[t], mt = Ft + fmaxf(m0, pm[t]);
            float den = 0.f;
#pragma unroll
            for (int sb = 0; sb < 8; ++sb)
#pragma unroll
                for (int i = 0; i < 4; ++i) { const int s = 16 * sb + 4 * g + i;
                    float p = 0.f; if (sb <= w && s <= t) p = st[sb][i] * __expf(Ft - Fc[s] + ig[s] - mt);
                    st[sb][i] = p; den += p; }
            den += shx(den, F.lane, 16); den += shx(den, F.lane, 32);
            f32x4 O1[4], O2[4];
#pragma unroll
            for (int db = 0; db < 4; ++db) { O1[db] = (f32x4){0.f, 0.f, 0.f, 0.f}; O2[db] = (f32x4){0.f, 0.f, 0.f, 0.f}; }
#pragma unroll
            for (int k2 = 0; k2 < 4; ++k2) { if (2 * k2 <= w) {
                u32x4 pw; pw.x = pk2(st[2 * k2][0], st[2 * k2][1]); pw.y = pk2(st[2 * k2][2], st[2 * k2][3]); pw.z = pk2(st[2 * k2 + 1][0], st[2 * k2 + 1][1]); pw.w = pk2(st[2 * k2 + 1][2], st[2 * k2 + 1][3]);
                const bf16x8 Pf = __builtin_bit_cast(bf16x8, pw);
#pragma unroll
                for (int db = 0; db < 4; ++db) { const LAS unsigned char* vr = L + ML_VT + (16 * db + l15) * 272 + (32 * k2 + 4 * g) * 2;
                    u32x4 vw; const u32x2 v0 = *(const LAS u32x2*)vr, v1 = *(const LAS u32x2*)(vr + 32); vw.x = v0.x; vw.y = v0.y; vw.z = v1.x; vw.w = v1.y;
                    O1[db] = PG8_MFMA(__builtin_bit_cast(bf16x8, vw), Pf, O1[db]); } } }
#pragma unroll
            for (int db = 0; db < 4; ++db)
#pragma unroll
                for (int ks = 0; ks < 2; ++ks) { const bf16x8 Cfr = *(const LAS bf16x8*)(L + ML_CB + (16 * db + l15) * 144 + (8 * g + 32 * ks) * 2); O2[db] = PG8_MFMA(Cfr, Qf[ks], O2[db]); }
            const float inter = __expf(Ft + m0 - mt);
            float nqv = 0.f;
#pragma unroll
            for (int ks = 0; ks < 2; ++ks) { const u32x4 qw = __builtin_bit_cast(u32x4, Qf[ks]); const LAS float* np = nf + 32 * ks + 8 * g;
                const f32x4 n0 = *(const LAS f32x4*)np, n1 = *(const LAS f32x4*)(np + 4);
                nqv += n0[0] * bflo(qw.x) + n0[1] * bfhi(qw.x) + n0[2] * bflo(qw.y) + n0[3] * bfhi(qw.y) + n1[0] * bflo(qw.z) + n1[1] * bfhi(qw.z) + n1[2] * bflo(qw.w) + n1[3] * bfhi(qw.w); }
            nqv += shx(nqv, F.lane, 16); nqv += shx(nqv, F.lane, 32);
            den += inter * nqv;
            const float dinv = 1.0f / fmaxf(fabsf(den), __expf(-mt));
            float ss = 0.f;
#pragma unroll
            for (int db = 0; db < 4; ++db)
#pragma unroll
                for (int i = 0; i < 4; ++i) { const float hv = (O1[db][i] + inter * O2[db][i]) * dinv; O1[db][i] = hv; ss += hv * hv; }
            ss += shx(ss, F.lane, 16); ss += shx(ss, F.lane, 32);
            const float rstd = rsqrtf(ss * (1.f / 64.f) + 1e-6f);
#pragma unroll
            for (int db = 0; db < 4; ++db) { const int d0 = 16 * db + 4 * g;
                const u32x2 ov = *(const GAS u32x2*)(P + (row0 + t) * NINP + PC_OB + 64 * h + d0);
                const f32x4 hg = *(const GAS f32x4*)(hn + d0);
                const float o0 = O1[db][0] * rstd * hg[0] * sigmoidf_(bflo(ov.x)), o1 = O1[db][1] * rstd * hg[1] * sigmoidf_(bfhi(ov.x));
                const float o2 = O1[db][2] * rstd * hg[2] * sigmoidf_(bflo(ov.y)), o3 = O1[db][3] * rstd * hg[3] * sigmoidf_(bfhi(ov.y));
                u32x2 o; o.x = pk2(o0, o1); o.y = pk2(o2, o3);
                *(GAS u32x2*)(YC + (row0 + t) * 1024 + 256 + 64 * h + d0) = o; }
        }
        __syncthreads();
    }
}

constexpr int SW_KS = 0, SW_VT = 36864;
__device__ __forceinline__ void swa_unit(Frame& F, int l, int u) {
    const int nb = u & 15, kvh = (u >> 4) & 1, b = u >> 5;
    LAS unsigned char* L = F.lds;
    const GAS bf16* P = WSP(bf16, WS_P); GAS bf16* YC = WSP(bf16, WS_YCAT);
    const GAS float* qg = INP(23) + (size_t)l * 64; const GAS float* kg = INP(24) + (size_t)l * 64; const GAS float* sinkp = INP(25) + (size_t)l * 8;
    const int lane = F.lane, l15 = lane & 15, g = lane >> 4, w = F.wave;
    u32x4 kvr[4], vvr[4];
#pragma unroll
    for (int j = 0; j < 4; ++j) { const int it = F.tid + NTHR * j, kx = it >> 3, c8 = (it & 7) * 8; const int pos = (nb - 1) * 128 + kx;
        const size_t row = (size_t)b * SEQ + (pos >= 0 ? pos : 0);
        kvr[j] = *(const GAS u32x4*)(P + row * NINP + PC_KC + 64 * kvh + c8); vvr[j] = *(const GAS u32x4*)(P + row * NINP + PC_VC + 64 * kvh + c8); }
    const f32x4 kg0 = *(const GAS f32x4*)(kg + (F.tid & 7) * 8), kg1 = *(const GAS f32x4*)(kg + (F.tid & 7) * 8 + 4);
    const float kgv[8] = {kg0[0], kg0[1], kg0[2], kg0[3], kg1[0], kg1[1], kg1[2], kg1[3]};
#pragma unroll
    for (int j = 0; j < 4; ++j) { const int it = F.tid + NTHR * j, kx = it >> 3, c8 = (it & 7) * 8; const int pos = (nb - 1) * 128 + kx;
        const u32x4 kv = keep4(pos >= 0, kvr[j]), vv = keep4(pos >= 0, vvr[j]);
        float kf[8]; float ss = 0.f;
#pragma unroll
        for (int e = 0; e < 4; ++e) { kf[2 * e] = bflo(kv[e]); kf[2 * e + 1] = bfhi(kv[e]); ss += kf[2 * e] * kf[2 * e] + kf[2 * e + 1] * kf[2 * e + 1]; }
        ss += shx(ss, F.lane, 1); ss += shx(ss, F.lane, 2); ss += shx(ss, F.lane, 4);
        const float rs = rsqrtf(ss * (1.f / 64.f) + 1e-6f);
        u32x4 ko;
#pragma unroll
        for (int e = 0; e < 4; ++e) ko[e] = pk2(kf[2 * e] * rs * kgv[2 * e], kf[2 * e + 1] * rs * kgv[2 * e + 1]);
        *(LAS u32x4*)(L + SW_KS + kx * 144 + c8 * 2) = ko;
#pragma unroll
        for (int e = 0; e < 4; ++e) { *(LAS bf16*)(L + SW_VT + (c8 + 2 * e) * 528 + kx * 2) = (bf16)(vv[e] & 0xffffu); *(LAS bf16*)(L + SW_VT + (c8 + 2 * e + 1) * 528 + kx * 2) = (bf16)(vv[e] >> 16); } }
    __syncthreads();
    const int hq = 4 * kvh + (w >> 1);
    const float slope = exp2f(-(float)(hq + 1)), sink = sinkp[hq];
    float qgv[16];
    { const f32x4 a0 = *(const GAS f32x4*)(qg + 8 * g), a1 = *(const GAS f32x4*)(qg + 8 * g + 4), a2 = *(const GAS f32x4*)(qg + 32 + 8 * g), a3 = *(const GAS f32x4*)(qg + 32 + 8 * g + 4);
#pragma unroll
      for (int e = 0; e < 4; ++e) { qgv[e] = a0[e]; qgv[4 + e] = a1[e]; qgv[8 + e] = a2[e]; qgv[12 + e] = a3[e]; } }
    const GAS bf16* qp = P + ((size_t)b * SEQ + nb * 128 + 64 * (w & 1) + l15) * NINP + PC_QC + 64 * hq + 8 * g;
    u32x4 qnx[2] = {*(const GAS u32x4*)qp, *(const GAS u32x4*)(qp + 32)};
    for (int qb = 0; qb < 4; ++qb) {
        const int q0 = 64 * (w & 1) + 16 * qb, qloc = q0 + l15, kb0 = q0 >> 4;
        const size_t row = (size_t)b * SEQ + nb * 128 + qloc;
        const u32x4 qcur[2] = {qnx[0], qnx[1]};
        { const GAS bf16* qn = qp + (size_t)(16 * (qb < 3 ? qb + 1 : 3)) * NINP; qnx[0] = *(const GAS u32x4*)qn; qnx[1] = *(const GAS u32x4*)(qn + 32); }
        bf16x8 Qf[2];
        { float qf[16]; float ss = 0.f;
#pragma unroll
          for (int ks = 0; ks < 2; ++ks) { const u32x4 qv = qcur[ks];
#pragma unroll
              for (int e = 0; e < 4; ++e) { qf[8 * ks + 2 * e] = bflo(qv[e]); qf[8 * ks + 2 * e + 1] = bfhi(qv[e]); } }
#pragma unroll
          for (int e = 0; e < 16; ++e) ss += qf[e] * qf[e];
          ss += shx(ss, F.lane, 16); ss += shx(ss, F.lane, 32);
          const float rs = rsqrtf(ss * (1.f / 64.f) + 1e-6f) * 0.125f;
#pragma unroll
          for (int ks = 0; ks < 2; ++ks) { u32x4 qo;
#pragma unroll
              for (int e = 0; e < 4; ++e) { qo[e] = pk2(qf[8 * ks + 2 * e] * rs * qgv[8 * ks + 2 * e], qf[8 * ks + 2 * e + 1] * rs * qgv[8 * ks + 2 * e + 1]); }
              Qf[ks] = __builtin_bit_cast(bf16x8, qo); } }
        f32x4 st[10];
#pragma unroll
        for (int j = 0; j < 10; ++j) { const int kbc = (kb0 + j) < 15 ? (kb0 + j) : 15; st[j] = (f32x4){0.f, 0.f, 0.f, 0.f};
#pragma unroll
            for (int ks = 0; ks < 2; ++ks) { const bf16x8 Kf = *(const LAS bf16x8*)(L + SW_KS + (16 * kbc + l15) * 144 + (8 * g + 32 * ks) * 2); st[j] = PG8_MFMA(Kf, Qf[ks], st[j]); } }
        float mx = -3.0e38f;
#pragma unroll
        for (int j = 0; j < 10; ++j)
#pragma unroll
            for (int i = 0; i < 4; ++i) { const int kx = 16 * (kb0 + j) + 4 * g + i, dist = 128 + qloc - kx;
                const bool valid = dist >= 0 && dist < 128 && (nb > 0 || kx >= 128);
                const float s = valid ? st[j][i] - slope * (float)dist : -3.0e38f; st[j][i] = s; mx = fmaxf(mx, s); }
        mx = fmaxf(mx, shx(mx, F.lane, 16)); mx = fmaxf(mx, shx(mx, F.lane, 32)); mx = fmaxf(mx, sink);
        float den = 0.f;
#pragma unroll
        for (int j = 0; j < 10; ++j)
#pragma unroll
            for (int i = 0; i < 4; ++i) { const float p = st[j][i] > -1.0e38f ? __expf(st[j][i] - mx) : 0.f; st[j][i] = p; den += p; }
        den += shx(den, F.lane, 16); den += shx(den, F.lane, 32); den += __expf(sink - mx);
        const float dinv = 1.0f / den;
        f32x4 O[4];
#pragma unroll
        for (int db = 0; db < 4; ++db) O[db] = (f32x4){0.f, 0.f, 0.f, 0.f};
#pragma unroll
        for (int k2 = 0; k2 < 5; ++k2) {
            u32x4 pw; pw.x = pk2(st[2 * k2][0] * dinv, st[2 * k2][1] * dinv); pw.y = pk2(st[2 * k2][2] * dinv, st[2 * k2][3] * dinv);
            pw.z = pk2(st[2 * k2 + 1][0] * dinv, st[2 * k2 + 1][1] * dinv); pw.w = pk2(st[2 * k2 + 1][2] * dinv, st[2 * k2 + 1][3] * dinv);
            const bf16x8 Pf = __builtin_bit_cast(bf16x8, pw);
            const int kc0 = (kb0 + 2 * k2) < 15 ? (kb0 + 2 * k2) : 15, kc1 = (kb0 + 2 * k2 + 1) < 15 ? (kb0 + 2 * k2 + 1) : 15;
#pragma unroll
            for (int db = 0; db < 4; ++db) { const LAS unsigned char* vr = L + SW_VT + (16 * db + l15) * 528;
                const u32x2 v0 = *(const LAS u32x2*)(vr + (16 * kc0 + 4 * g) * 2), v1 = *(const LAS u32x2*)(vr + (16 * kc1 + 4 * g) * 2);
                u32x4 vw; vw.x = v0.x; vw.y = v0.y; vw.z = v1.x; vw.w = v1.y;
                O[db] = PG8_MFMA(__builtin_bit_cast(bf16x8, vw), Pf, O[db]); } }
#pragma unroll
        for (int db = 0; db < 4; ++db) { u32x2 o; o.x = pk2(O[db][0], O[db][1]); o.y = pk2(O[db][2], O[db][3]);
            *(GAS u32x2*)(YC + row * 1024 + 512 + 64 * hq + 16 * db + 4 * g) = o; }
    }
    __syncthreads();
}

constexpr int RT_HS = 0, RT_HSTRIDE = 2064, RT_LG = 64 * 2064, RT_CNT = RT_LG + 48 * 64 * 4, RT_BASE = RT_CNT + 128;
__device__ __forceinline__ void phase_router(Frame& F, int l) {
    LAS unsigned char* L = F.lds;
    LAS float* lg = (LAS float*)(L + RT_LG);
    LAS int* ecnt = (LAS int*)(L + RT_CNT); LAS int* ebase = (LAS int*)(L + RT_BASE); LAS float* biasT = (LAS float*)(L + RT_BASE + 256);
    const GAS float* g2 = INP(5) + (size_t)l * 1024;
    const GAS float* brg = INP(31) + (size_t)l * 4; const GAS float* bre = INP(33) + (size_t)l * 32;
    const GAS bf16* wrt = WSP(bf16, WS_WRT) + (size_t)l * 48 * 1024;
    GAS unsigned* cnt = WSP(unsigned, WS_CTL) + CW_CNT + l * 32;
    GAS int* LIST = WSP(int, WS_LIST); GAS int* ROUTE = WSP(int, WS_ROUTE);
    const int l15 = F.lane & 15, g = F.lane >> 4;
    for (int tile = F.bid; tile < NT / 64; tile += F.G) {
        const int r0 = tile * 64, b = r0 / SEQ;
        const GAS float* mb = WSP(float, WS_MOD) + ((size_t)l * 8 + b) * 6144;
        if (F.tid < 32) ecnt[F.tid] = 0;
        if (F.tid >= 64 && F.tid < 112) { const int o = F.tid - 64; biasT[o] = o < 4 ? brg[o] : (o < 36 ? bre[o - 4] : 0.f); }
        {   u32x4 xw[8][2];
            const unsigned c0 = 8 * F.lane;
#pragma unroll
            for (int rr = 0; rr < 8; ++rr)
#pragma unroll
                for (int jj = 0; jj < 2; ++jj) xw[rr][jj] = *(const GAS u32x4*)(WSP(bf16, WS_X1) + (size_t)(r0 + 8 * F.wave + rr) * 1024 + c0 + 512 * jj);
            f32x4 gsc[4], shv[4];
#pragma unroll
            for (int q = 0; q < 4; ++q) { const unsigned col = c0 + 512 * (q >> 1) + 4 * (q & 1);
                const f32x4 gg = *(const GAS f32x4*)(g2 + col), sc = *(const GAS f32x4*)(mb + 4 * 1024 + col); gsc[q] = gg * (sc + 1.0f); shv[q] = *(const GAS f32x4*)(mb + 3 * 1024 + col); }
#pragma unroll
            for (int rr = 0; rr < 8; ++rr) { const int r = 8 * F.wave + rr; const size_t row = (size_t)(r0 + r);
                f32x4 v[4]; float ss = 0.f;
#pragma unroll
                for (int q = 0; q < 4; ++q) { const u32x4 xx = xw[rr][q >> 1]; const unsigned x0 = (q & 1) ? xx.z : xx.x, x1 = (q & 1) ? xx.w : xx.y;
                    v[q] = (f32x4){bflo(x0), bfhi(x0), bflo(x1), bfhi(x1)}; ss += (v[q][0] * v[q][0] + v[q][1] * v[q][1]) + (v[q][2] * v[q][2] + v[q][3] * v[q][3]); }
                const float rstd = rsqrtf(wave_sum(ss) * (1.f / 1024.f) + 1e-6f);
                f32x4 hv[4];
#pragma unroll
                for (int q = 0; q < 4; ++q) hv[q] = v[q] * rstd * gsc[q] + shv[q];
#pragma unroll
                for (int jj = 0; jj < 2; ++jj) { u32x4 o; o.x = pk2(hv[2 * jj][0], hv[2 * jj][1]); o.y = pk2(hv[2 * jj][2], hv[2 * jj][3]); o.z = pk2(hv[2 * jj + 1][0], hv[2 * jj + 1][1]); o.w = pk2(hv[2 * jj + 1][2], hv[2 * jj + 1][3]);
                    u32x2 o8; o8.x = pk4_fp8(hv[2 * jj][0], hv[2 * jj][1], hv[2 * jj][2], hv[2 * jj][3]); o8.y = pk4_fp8(hv[2 * jj + 1][0], hv[2 * jj + 1][1], hv[2 * jj + 1][2], hv[2 * jj + 1][3]);
                    *(GAS u32x2*)(WSP(unsigned char, WS_H) + row * 1024 + c0 + 512 * jj) = o8;
                    *(LAS u32x4*)(L + RT_HS + r * RT_HSTRIDE + (c0 + 512 * jj) * 2) = o; } } }
        __syncthreads();
        { const int tb = F.wave & 3, kh = F.wave >> 2;
          f32x4 acc[3] = {(f32x4){0.f, 0.f, 0.f, 0.f}, (f32x4){0.f, 0.f, 0.f, 0.f}, (f32x4){0.f, 0.f, 0.f, 0.f}};
          const LAS unsigned char* hb = L + RT_HS + (16 * tb + l15) * RT_HSTRIDE + (512 * kh + 8 * g) * 2;
          const GAS bf16* wb = wrt + (size_t)l15 * 1024 + 512 * kh + 8 * g;
#pragma unroll
          for (int k4 = 0; k4 < 4; ++k4) {
              bf16x8 Af[4][3];
#pragma unroll
              for (int kq = 0; kq < 4; ++kq)
#pragma unroll
                  for (int ob = 0; ob < 3; ++ob) Af[kq][ob] = *(const GAS bf16x8*)(wb + (size_t)ob * 16 * 1024 + (4 * k4 + kq) * 32);
              __builtin_amdgcn_sched_barrier(0);
#pragma unroll
              for (int kq = 0; kq < 4; ++kq) { const bf16x8 Bf = *(const LAS bf16x8*)(hb + (4 * k4 + kq) * 64);
#pragma unroll
                  for (int ob = 0; ob < 3; ++ob) acc[ob] = PG8_MFMA(Af[kq][ob], Bf, acc[ob]); }
              __builtin_amdgcn_sched_barrier(0); }
          if (kh == 1) {
#pragma unroll
              for (int ob = 0; ob < 3; ++ob)
#pragma unroll
                  for (int i = 0; i < 4; ++i) lg[(16 * ob + 4 * g + i) * 64 + 16 * tb + l15] = acc[ob][i]; }
          __syncthreads();
          if (kh == 0) {
#pragma unroll
              for (int ob = 0; ob < 3; ++ob)
#pragma unroll
                  for (int i = 0; i < 4; ++i) { const int o = 16 * ob + 4 * g + i; const float bias = biasT[o];
                      lg[o * 64 + 16 * tb + l15] += acc[ob][i] + bias; } } }
        __syncthreads();
        int e1 = 0, e2 = 0, li1 = 0, li2 = 0; float w1 = 0.f, w2 = 0.f;
        if (F.tid < 64) { float lr[36];
#pragma unroll
            for (int j = 0; j < 36; ++j) lr[j] = lg[j * 64 + F.tid];
            int gi = 0; float gm = lr[0];
#pragma unroll
            for (int j = 1; j < 4; ++j) if (lr[j] > gm) { gm = lr[j]; gi = j; }
            float gs = 0.f;
#pragma unroll
            for (int j = 0; j < 4; ++j) gs += __expf(lr[j] - gm);
            const float gtop = 1.0f / gs;
            float er[8];
#pragma unroll
            for (int j = 0; j < 8; ++j) er[j] = gi == 0 ? lr[4 + j] : (gi == 1 ? lr[12 + j] : (gi == 2 ? lr[20 + j] : lr[28 + j]));
            int i1 = 0; float m1 = er[0];
#pragma unroll
            for (int j = 1; j < 8; ++j) if (er[j] > m1) { m1 = er[j]; i1 = j; }
            int i2 = -1; float m2 = -3.0e38f;
#pragma unroll
            for (int j = 0; j < 8; ++j) if (j != i1 && er[j] > m2) { m2 = er[j]; i2 = j; }
            const float x2 = __expf(m2 - m1); w1 = gtop / (1.0f + x2); w2 = gtop * x2 / (1.0f + x2);
            e1 = 8 * gi + i1; e2 = 8 * gi + i2;
            li1 = __hip_atomic_fetch_add(&ecnt[e1], 1, __ATOMIC_RELAXED, __HIP_MEMORY_SCOPE_WORKGROUP); li2 = __hip_atomic_fetch_add(&ecnt[e2], 1, __ATOMIC_RELAXED, __HIP_MEMORY_SCOPE_WORKGROUP); }
        __syncthreads();
        if (F.tid < 32) ebase[F.tid] = (int)__hip_atomic_fetch_add(cnt + F.tid, (unsigned)ecnt[F.tid], __ATOMIC_RELAXED, __HIP_MEMORY_SCOPE_AGENT);
        __syncthreads();
        if (F.tid < 64) { const int tok = r0 + F.tid; const int p1 = ebase[e1] + li1, p2 = ebase[e2] + li2;
            LIST[e1 * NT + p1] = tok; LIST[e2 * NT + p2] = tok;
            GAS int* rt = ROUTE + (size_t)tok * 8; *(GAS u32x2*)rt = (u32x2){(unsigned)e1, (unsigned)e2}; *(GAS u32x4*)(rt + 4) = (u32x4){__float_as_uint(w1), __float_as_uint(w2), (unsigned)p1, (unsigned)p2}; }
        __syncthreads();
    }
}
__device__ __forceinline__ void phase_scatter(Frame& F, int l) {
    LAS int* part = (LAS int*)F.lds;
    LAS int* base = part + 1024;
    const GAS int* CT = WSP(int, WS_CNTT) + (size_t)l * 256 * 32;
    GAS int* LIST = WSP(int, WS_LIST); GAS int* ROUTE = WSP(int, WS_ROUTE);
    for (int tile = F.bid; tile < NT / 64; tile += F.G) {
        { const int e = F.tid & 31, pt = F.tid >> 5; int sb = 0, st = 0;
          int cq[16];
#pragma unroll
          for (int q = 0; q < 16; ++q) cq[q] = CT[(16 * pt + q) * 32 + e];
          __builtin_amdgcn_sched_barrier(0);
#pragma unroll
          for (int q = 0; q < 16; ++q) { const int t2 = 16 * pt + q; const int c = cq[q]; st += c; sb += (t2 < tile) ? c : 0; }
          part[pt * 32 + e] = sb; part[512 + pt * 32 + e] = st; }
        __syncthreads();
        if (F.tid < 32) { int sb = 0, st = 0;
#pragma unroll
            for (int q = 0; q < 16; ++q) { sb += part[q * 32 + F.tid]; st += part[512 + q * 32 + F.tid]; }
            base[F.tid] = sb;
            if (tile == 0) WSP(unsigned, WS_CTL)[CW_CNT + l * 32 + F.tid] = (unsigned)st; }
        __syncthreads();
        if (F.tid < 64) { const int tok = tile * 64 + F.tid; GAS int* rt = ROUTE + (size_t)tok * 8;
            const u32x4 r4 = *(const GAS u32x4*)rt; const int e1 = (int)r4.x, e2 = (int)r4.y, p1 = base[e1] + (int)r4.z, p2 = base[e2] + (int)r4.w;
            LIST[e1 * NT + p1] = tok; LIST[e2 * NT + p2] = tok; rt[6] = p1; rt[7] = p2; }
        __syncthreads();
    }
}

#ifndef MK_ONE_LAUNCH
#ifndef MK_ONE_LAUNCH
#define MK_ONE_LAUNCH 1
#endif
#endif
#ifndef MK_SIMPLE_GEMM
#define MK_SIMPLE_GEMM 0
#endif
#if MK_SIMPLE_GEMM
#define RUN_GEMM(EPI, SCHED, GATHER, g, S, E) pg8::gemm_simple<EPI, SCHED, GATHER>(F.tid, g, S, E)
#else
#define RUN_GEMM(EPI, SCHED, GATHER, g, S, E) pg8::gemm_phase<EPI, SCHED, GATHER>(F.tid, F.lds, g, S, E)
#endif
__global__ void __launch_bounds__(NTHR, 2) fwd(Args args) {
    extern __shared__ __attribute__((aligned(16))) unsigned char lds_raw[];
    Frame F;
    F.lds = (LAS unsigned char*)lds_raw;
    const int wave0 = __builtin_amdgcn_readfirstlane((int)threadIdx.x >> 6);
    F.wave = wave0; F.lane = (int)__builtin_amdgcn_mbcnt_hi(~0u, __builtin_amdgcn_mbcnt_lo(~0u, 0u)); F.tid = wave0 * 64 + F.lane; F.G = gridDim.x; F.bid = blockIdx.x;
    F.in = args.in; F.out = (GAS float*)args.out; F.ws = args.ws;
    volatile LAS unsigned* MISC = (volatile LAS unsigned*)(F.lds + LDS_MISC);
    if (F.tid < 64) MISC[F.tid] = 0u;
    __syncthreads();
    const int lo = args.ph_lo, hi = args.ph_hi;
    XcdBarrier bar; bar.bar = (unsigned*)(WSP(unsigned, WS_CTL) + CW_BAR); bar.x = 0; bar.st = MISC + 8;
    if (hi - lo > 1) bar = xcd_barrier_post((unsigned*)(WSP(unsigned, WS_CTL) + CW_BAR), MISC + 8, F.tid);
#ifndef MK_PH_MASK
#define MK_PH_MASK 0xfff
#endif
#define IN(k) (opaque_s(lo) <= (k) && (k) < opaque_s(hi))
#define EN(j) (((MK_PH_MASK) >> (j)) & 1)
#ifndef MK_REPS
#define MK_REPS 1,1,1,1,1,1,1,1,1,1,1,1
#endif
    constexpr int REPS[12] = {MK_REPS};
#define REFRESH() do { int l_; asm volatile("v_mbcnt_lo_u32_b32 %0, -1, 0\n\tv_mbcnt_hi_u32_b32 %0, -1, %0" : "=v"(l_)); F.lane = l_; F.wave = wave0; F.tid = wave0 * 64 + l_; } while (0)
#define SEAM(k) do { if ((k) + 1 < opaque_s(hi)) { REFRESH(); xcd_barrier(bar, F.tid); } } while (0)
    if (EN(0) && IN(0)) for (int rep = 0; rep < REPS[0]; ++rep) { REFRESH(); p0_prologue(F); REFRESH(); convert_layer(F, 0, F.bid, F.G); SEAM(0); }
    for (int l = 0; l < DEPTH; ++l) {
        const int pb = 1 + l * NPH_LAYER;
        if (EN(1) && IN(pb + 0)) for (int rep = 0; rep < REPS[1]; ++rep) { REFRESH(); phase_norm1(F, l); SEAM(pb + 0); }
        if (EN(2) && IN(pb + 1)) for (int rep = 0; rep < REPS[2]; ++rep) { REFRESH();
#pragma unroll 1
            for (int it_ = 0; it_ < 2; ++it_) { REFRESH();
              if ((it_ ^ (F.bid & 1)) == 0) {
            { pg8::Gemm g{WSP(bf16, WS_H), WSP(bf16, WS_WTIN) + (size_t)l * NINP * 1024, 1024, 1024, nullptr};
              pg8::SchedPlain S{64, 12, 16, F.G, F.bid}; pg8::EpiStoreBf16 E{WSP(bf16, WS_P), NINP, 1.f};
              RUN_GEMM(pg8::EpiStoreBf16, pg8::SchedPlain, false, g, S, E); }
              } else {
            { pg8::Gemm g{(const GAS bf16*)WSP(unsigned char, WS_H8), (const GAS bf16*)(WSP(unsigned char, WS_WTIN8) + (size_t)l * 3072 * 1024), 1024, 1024, nullptr};
              pg8::SchedPlain S{64, 12, 8, F.G, F.bid}; pg8::EpiGateU8 E{WSP(unsigned char, WS_P) + 2 * PC_GATE, 1.f / F8S_WIN};
              pg8::gemm_phase<pg8::EpiGateU8, pg8::SchedPlain, false, 1>(F.tid, F.lds, g, S, E); }
              } }
            SEAM(pb + 1); }
        if (EN(4) && IN(pb + 3)) for (int rep = 0; rep < REPS[4]; ++rep) {
#pragma unroll 1
            for (int it_ = 0; it_ < 3; ++it_) { REFRESH();
              const int og_ = F.bid & 3, part_ = og_ == 0 ? it_ : (og_ == 1 ? (it_ + 1) % 3 : (og_ == 2 ? (it_ + 2) % 3 : (it_ == 0 ? 1 : (it_ == 1 ? 0 : 2))));
              if (part_ == 0) {
                phase_prep(F, l);
                VM_WAIT(); __syncthreads();
                REFRESH();
                for (int gq = F.bid; gq < 32 * SC_NCH / 4; gq += F.G) scan_local_block(F, l, gq);
              } else if (part_ == 1) {
                for (int u = F.bid; u < 512; u += F.G) mlstm_summary_unit(F, l, u);
              } else {
                for (int u = F.bid; u < 256; u += F.G) swa_unit(F, l, u);
              }
              __syncthreads(); }
            REFRESH(); xcd_barrier(bar, F.tid);
            REFRESH();
            if (F.bid < 32) scan_combine_unit(F, l, F.bid);
            else {
#pragma unroll 1
                for (int it_ = 0; it_ < 2; ++it_) { REFRESH();
                    if ((it_ ^ (F.bid & 1)) == 0) { for (int u = F.bid - 32; u < 512; u += F.G - 32) mlstm_output_unit(F, l, u); }
                    else {
                        pg8::Gemm g{WSP(bf16, WS_YCAT), WSP(bf16, WS_WTBR) + (size_t)l * 1024 * 1024, 1024, 1024, nullptr};
                        pg8::SchedMerge S{F.G - 32, F.G - 1 - F.bid, 2, 1, 0}; pg8::EpiMerge E{WSP(bf16, WS_MERGED), WSP(bf16, WS_P)};
                        RUN_GEMM(pg8::EpiMerge, pg8::SchedMerge, false, g, S, E); }
                    __syncthreads(); } }
            SEAM(pb + 3); }
        if (EN(6) && IN(pb + 5)) for (int rep = 0; rep < REPS[6]; ++rep) { REFRESH();
            pg8::Gemm g{WSP(bf16, WS_YCAT), WSP(bf16, WS_WTBR) + (size_t)l * 1024 * 1024, 1024, 1024, nullptr};
            pg8::SchedMergeAB S{F.G, F.bid}; pg8::EpiMergeAB E{WSP(bf16, WS_MERGED), WSP(bf16, WS_P)};
            RUN_GEMM(pg8::EpiMergeAB, pg8::SchedMergeAB, false, g, S, E);
            SEAM(pb + 5); }
        if (EN(7) && IN(pb + 6)) for (int rep = 0; rep < REPS[7]; ++rep) { REFRESH();
            pg8::Gemm g{WSP(bf16, WS_MERGED), WSP(bf16, WS_WTOUT) + (size_t)l * 1024 * 1024, 1024, 1024, nullptr};
            pg8::SchedPlain S{64, 4, 16, F.G, F.bid};
            pg8::EpiRes E{l == 0 ? INP(0) : (const GAS float*)nullptr, WSP(bf16, WS_XA), WSP(bf16, WS_X1), WSP(float, WS_MOD) + (size_t)l * 8 * 6144 + 2048};
            RUN_GEMM(pg8::EpiRes, pg8::SchedPlain, false, g, S, E);
            SEAM(pb + 6); }
        if (EN(8) && IN(pb + 7)) for (int rep = 0; rep < REPS[8]; ++rep) { REFRESH(); phase_router(F, l); SEAM(pb + 7); }
        if (EN(9) && IN(pb + 8)) for (int rep = 0; rep < REPS[9]; ++rep) {
            REFRESH(); LAS int* tp = (LAS int*)(F.lds + 131072); build_tp(F, l, tp);
            pg8::Gemm g{WSP(bf16, WS_H), (const GAS bf16*)(WSP(unsigned char, WS_WTEIN) + (size_t)l * NEXP * 1024 * 1024), 1024, 1024, WSP(int, WS_LIST)};
            pg8::SchedMoE S{tp, F.G, F.bid, 8, 1}; pg8::EpiAct E{WSP(unsigned char, WS_ACT), 1.f / F8S_EIN};
            pg8::gemm_phase<pg8::EpiAct, pg8::SchedMoE, true, 1>(F.tid, F.lds, g, S, E);
            SEAM(pb + 8); }
        if (EN(10) && IN(pb + 9)) for (int rep = 0; rep < REPS[10]; ++rep) {
            REFRESH(); LAS int* tp = (LAS int*)(F.lds + 131072);
#if !MK_ONE_LAUNCH
            build_tp(F, l, tp);
#endif
            pg8::Gemm g{WSP(bf16, WS_ACT), (const GAS bf16*)(WSP(unsigned char, WS_WTEOUT) + (size_t)l * NEXP * 1024 * 512), 512, 512, nullptr};
            pg8::SchedMoE S{tp, F.G, F.bid, 4, 0}; pg8::EpiStoreFp8 E{WSP(unsigned char, WS_YB), 1024, 1.f / F8S_EOUT};
            pg8::gemm_phase<pg8::EpiStoreFp8, pg8::SchedMoE, false, 1>(F.tid, F.lds, g, S, E);
            SEAM(pb + 9); }
    }
    if (EN(11) && IN(NPHASES - 1)) { REFRESH(); phase_final(F); }
#undef IN
#undef SEAM
}

extern "C" void kernel_launch(void* const* d_in, const int* in_sizes, int n_in, void* d_out, int out_size, void* d_ws, size_t ws_size, hipStream_t stream) {
    static int grid = 0;
    if (grid == 0) {
        if (n_in != 36 || in_sizes[0] != NT * D || out_size != NT * D || ws_size < WS_END) {
            fprintf(stderr, "kernel_launch: unexpected shapes (n_in %d, in0 %d, out %d, ws %zu); nothing launched\n", n_in, n_in > 0 ? in_sizes[0] : -1, out_size, ws_size); grid = -1; return; }
        int dev = 0, cus = 0, per_cu = 0;
        if (hipGetDevice(&dev) != hipSuccess || hipDeviceGetAttribute(&cus, hipDeviceAttributeMultiprocessorCount, dev) != hipSuccess) { grid = -1; return; }
        if (hipFuncSetAttribute((const void*)fwd, hipFuncAttributeMaxDynamicSharedMemorySize, LDS_BYTES) != hipSuccess) { fprintf(stderr, "kernel_launch: hipFuncSetAttribute failed\n"); grid = -1; return; }
        if (hipOccupancyMaxActiveBlocksPerMultiprocessor(&per_cu, (const void*)fwd, NTHR, LDS_BYTES) != hipSuccess || per_cu < 1) fprintf(stderr, "kernel_launch: occupancy query reports %d\n", per_cu);
        (void)hipGetLastError();
        grid = cus;
        if (grid != 256) fprintf(stderr, "kernel_launch: %d CUs; this build is laid out for 256\n", grid);
    }
    if (grid < 0) return;
    (void)hipMemsetAsync((char*)d_ws + WS_CTL, 0, CTL_ZERO_BYTES, stream);
    Args a{};
    for (int i = 0; i < 36; ++i) a.in[i] = (const float*)d_in[i];
    a.out = (float*)d_out; a.ws = (unsigned char*)d_ws;
#if MK_ONE_LAUNCH
    a.ph_lo = 0; a.ph_hi = NPHASES;
    hipLaunchKernelGGL(fwd, dim3(grid), dim3(NTHR), LDS_BYTES, stream, a);
#else
    for (int p = 0; p < NPHASES; ++p) { a.ph_lo = p; a.ph_hi = p + 1; hipLaunchKernelGGL(fwd, dim3(grid), dim3(NTHR), LDS_BYTES, stream, a); }
#endif
}
```
